# Optimizing an MI355X kernel written in HIP

```python
import jax, jax.numpy as jnp
from jax import lax
import numpy as np

D_MODEL = 1024
BATCH = 4
SEQ = 8192
DEPTH = 4

GRID_W = 64
CTX_LEN = 256
N_MIXERS = 3
CHUNK = 128
NORM_EPS = 1e-6
RET_HEADS = 4
RET_QK_DIM = 256
RET_V_DIM = 512
RET_QK_WIDTH = RET_HEADS * RET_QK_DIM
RET_WIDTH = RET_HEADS * RET_V_DIM
ROPE_BASE = 10000.0
GM_WIDTH = 2 * D_MODEL
GM_GROUPS = 8
RW_HEAD = 64
RW_WIDTH = D_MODEL
RW_HEADS = RW_WIDTH // RW_HEAD
RW_LORA = 64
RW_LNX_EPS = 64e-5

N_RET = len(range(0, DEPTH, N_MIXERS))
N_GM = len(range(1, DEPTH, N_MIXERS))
N_RW = len(range(2, DEPTH, N_MIXERS))

kernel_name = 'hybrid_retention_gmlp_rwkv7_prefix_dit'

F32 = jnp.float32


def rmsnorm(x, g):
    xf = x.astype(F32)
    y = xf * lax.rsqrt(jnp.mean(xf * xf, axis=-1, keepdims=True) + NORM_EPS)
    return (y * g.astype(F32)).astype(x.dtype)


def to_heads(t, n_heads):
    b, l, _ = t.shape
    return t.reshape(b, l, n_heads, -1).transpose(0, 2, 1, 3).astype(F32)


def axial_rope(t, row, col):
    dk = t.shape[-1]
    n_freq = dk // 4
    freqs = ROPE_BASE ** (-jnp.arange(n_freq, dtype=F32) / n_freq)
    ang = jnp.concatenate([row.astype(F32)[:, None] * freqs, col.astype(F32)[:, None] * freqs], axis=-1)
    cos, sin = jnp.cos(ang), jnp.sin(ang)
    t1, t2 = t[..., :dk // 2], t[..., dk // 2:]
    return jnp.concatenate([t1 * cos - t2 * sin, t1 * sin + t2 * cos], axis=-1)


def retention_chunkwise(q, k, v, log_g, state0):
    b, h, l, _ = q.shape
    n = l // CHUNK

    def blocks(t):
        return jnp.moveaxis(t.reshape(b, h, n, CHUNK, t.shape[-1]), 2, 0)

    idx = jnp.arange(CHUNK, dtype=F32)
    diff = idx[:, None] - idx[None, :]
    intra = jnp.where(diff >= 0, jnp.exp(jnp.maximum(diff, 0.0)[None] * log_g[:, None, None]), 0.0)
    q_decay = jnp.exp((idx + 1.0)[None, :] * log_g[:, None])[:, :, None]
    k_decay = jnp.exp((CHUNK - 1.0 - idx)[None, :] * log_g[:, None])[:, :, None]
    chunk_decay = jnp.exp(CHUNK * log_g)[:, None, None]

    def step(s, blk):
        qb, kb, vb = blk
        scores = jnp.einsum('bhid,bhjd->bhij', qb, kb) * intra
        o = jnp.einsum('bhij,bhjv->bhiv', scores, vb) + jnp.einsum('bhid,bhdv->bhiv', qb * q_decay, s)
        s = s * chunk_decay + jnp.einsum('bhjd,bhjv->bhdv', kb * k_decay, vb)
        return s, o

    s_final, o = lax.scan(step, state0, (blocks(q), blocks(k), blocks(v)))
    o = jnp.moveaxis(o, 0, 2).reshape(b, h, l, v.shape[-1])
    return o, s_final


def retention_bidirectional(q, k, v, log_g, s_fwd, s_bwd):
    o_f, st_f = retention_chunkwise(q, k, v, log_g[0], s_fwd)
    o_b, st_b = retention_chunkwise(jnp.flip(q, 2), jnp.flip(k, 2), jnp.flip(v, 2), log_g[1], s_bwd)
    return o_f + jnp.flip(o_b, 2), st_f, st_b


def retention_project(h, w_in):
    a, bq, cq = RET_QK_WIDTH, 2 * RET_QK_WIDTH, 2 * RET_QK_WIDTH + RET_WIDTH
    q = to_heads(h @ w_in[:, :a], RET_HEADS)
    k = to_heads(h @ w_in[:, a:bq], RET_HEADS) * (RET_QK_DIM ** -0.5)
    v = to_heads(h @ w_in[:, bq:cq], RET_HEADS)
    z = h @ w_in[:, cq:]
    return q, k, v, z


def retention_output(o, z, w_out):
    o = o * lax.rsqrt(jnp.mean(o * o, axis=-1, keepdims=True) + NORM_EPS)
    b, h, l, dv = o.shape
    o = o.transpose(0, 2, 1, 3).reshape(b, l, h * dv).astype(z.dtype)
    return (o * jax.nn.silu(z)) @ w_out


def retention_mixer(hx, hc, w_in, decay_logit, w_out, need_ctx):
    l = hx.shape[1]
    t = jnp.arange(l, dtype=jnp.int32)
    row, col = t // GRID_W, t % GRID_W
    log_g = jax.nn.log_sigmoid(decay_logit.astype(F32))
    qc, kc, vc, zc = retention_project(hc, w_in)
    qx, kx, vx, zx = retention_project(hx, w_in)
    qx, kx = axial_rope(qx, row, col), axial_rope(kx, row, col)
    zero = jnp.zeros((hx.shape[0], RET_HEADS, RET_QK_DIM, RET_V_DIM), F32)
    oc, s_f, s_b = retention_bidirectional(qc, kc, vc, log_g, zero, zero)
    ox, _, _ = retention_bidirectional(qx, kx, vx, log_g, s_f, s_b)
    out_x = retention_output(ox, zx, w_out)
    out_c = retention_output(oc, zc, w_out) if need_ctx else None
    return out_x, out_c


def gmlp_chunk_mixer(h, w_in, vnorm_g, w_s, b_s, w_out):
    u = h @ w_in[:, :GM_WIDTH]
    v = (h @ w_in[:, GM_WIDTH:2 * GM_WIDTH]).astype(F32)
    z = h @ w_in[:, 2 * GM_WIDTH:]
    v = v - jnp.mean(v, axis=-1, keepdims=True)
    v = v * lax.rsqrt(jnp.mean(v * v, axis=-1, keepdims=True) + NORM_EPS) * vnorm_g.astype(F32)
    b, l, w = v.shape
    vg = v.reshape(b, l // CHUNK, CHUNK, GM_GROUPS, w // GM_GROUPS)
    mixed = jnp.einsum('gij,bnjgc->bnigc', w_s.astype(F32), vg) + b_s.astype(F32).T[:, :, None]
    y = u * mixed.reshape(b, l, w).astype(u.dtype)
    return (y * jax.nn.silu(z)) @ w_out


def token_shift_grid(h):
    l, b, d = h.shape
    rows = l // GRID_W
    g = h.reshape(rows, GRID_W, b, d)
    q = d // 4
    left = jnp.pad(g[:, :-1, :, :q], ((0, 0), (1, 0), (0, 0), (0, 0)))
    right = jnp.pad(g[:, 1:, :, q:2 * q], ((0, 0), (0, 1), (0, 0), (0, 0)))
    up = jnp.pad(g[:-1, :, :, 2 * q:3 * q], ((1, 0), (0, 0), (0, 0), (0, 0)))
    down = jnp.pad(g[1:, :, :, 3 * q:], ((0, 1), (0, 0), (0, 0), (0, 0)))
    return jnp.concatenate([left, right, up, down], axis=-1).reshape(l, b, d)


def token_shift_seq(h):
    half = h.shape[-1] // 2
    prev = jnp.pad(h[:-1, :, :half], ((1, 0), (0, 0), (0, 0)))
    nxt = jnp.pad(h[1:, :, half:], ((0, 1), (0, 0), (0, 0)))
    return jnp.concatenate([prev, nxt], axis=-1)


def rwkv_prepare(h, shifted, mu, w_rkvg, w0, w1, w2, a0, a1, a2, k_k, k_a):
    l, b, _ = h.shape
    xx = shifted - h

    def mix(p):
        return h + xx * mu[p]

    def heads(t):
        return t.astype(F32).reshape(l, b, RW_HEADS, RW_HEAD)

    r = heads(mix(0) @ w_rkvg[0])
    k = heads(mix(2) @ w_rkvg[1])
    v = heads(mix(3) @ w_rkvg[2])
    z = mix(5) @ w_rkvg[3]
    xw, xa = mix(1), mix(4)
    kk = k * k_k.astype(F32).reshape(RW_HEADS, RW_HEAD)
    kk = kk / jnp.maximum(jnp.sqrt(jnp.sum(kk * kk, axis=-1, keepdims=True)), 1e-12)
    k_a_h = k_a.astype(F32).reshape(RW_HEADS, RW_HEAD)
    dirs = []
    for d in range(2):
        w_log = -jax.nn.softplus(-(w0[d] + jnp.tanh(xw @ w1[d]) @ w2[d]).astype(F32)) - 0.5
        dec = heads(jnp.exp(-jnp.exp(w_log)))
        a = heads(jax.nn.sigmoid((a0[d] + (xa @ a1[d]) @ a2[d]).astype(F32)))
        dirs.append((dec, a, k * (1.0 + (a - 1.0) * k_a_h)))
    return r, v, kk, z, dirs


def wkv_scan(state0, r, dec, k, v, kk, a, reverse):
    def step(s, inp):
        r_t, w_t, k_t, v_t, kk_t, a_t = inp
        sa = jnp.einsum('bhvk,bhk->bhv', s, -kk_t)
        s = s * w_t[:, :, None, :] + sa[..., None] * (kk_t * a_t)[:, :, None, :] + v_t[..., None] * k_t[:, :, None, :]
        return s, jnp.einsum('bhvk,bhk->bhv', s, r_t)

    s_final, y = lax.scan(step, state0, (r, dec, k, v, kk, a), reverse=reverse)
    return y, s_final


def rwkv_bidirectional(prep, states):
    r, v, kk, _, dirs = prep
    y_f, s_f = wkv_scan(states[0], r, dirs[0][0], dirs[0][2], v, kk, dirs[0][1], False)
    y_b, s_b = wkv_scan(states[1], r, dirs[1][0], dirs[1][2], v, kk, dirs[1][1], True)
    return y_f + y_b, (s_f, s_b)


def rwkv_output(prep, y, r_k, lnx_g, lnx_b, w_out):
    r, v, _, z, dirs = prep
    l, b, h, d = y.shape
    yc = y - jnp.mean(y, axis=-1, keepdims=True)
    yn = yc * lax.rsqrt(jnp.mean(yc * yc, axis=-1, keepdims=True) + RW_LNX_EPS)
    yn = yn.reshape(l, b, h * d) * lnx_g.astype(F32) + lnx_b.astype(F32)
    rk = r_k.astype(F32)
    bonus = (jnp.sum(r * dirs[0][2] * rk, axis=-1, keepdims=True)
             + jnp.sum(r * dirs[1][2] * rk, axis=-1, keepdims=True)) * v
    o = (yn + bonus.reshape(l, b, h * d)).astype(z.dtype) * jax.nn.silu(z)
    return (o @ w_out).transpose(1, 0, 2)


def rwkv_mixer(hx, hc, mu, w_rkvg, w0, w1, w2, a0, a1, a2, k_k, k_a, r_k, lnx_g, lnx_b, w_out, need_ctx):
    hx_t = hx.transpose(1, 0, 2)
    hc_t = hc.transpose(1, 0, 2)
    prep_c = rwkv_prepare(hc_t, token_shift_seq(hc_t), mu, w_rkvg, w0, w1, w2, a0, a1, a2, k_k, k_a)
    prep_x = rwkv_prepare(hx_t, token_shift_grid(hx_t), mu, w_rkvg, w0, w1, w2, a0, a1, a2, k_k, k_a)
    zero = jnp.zeros((hx.shape[0], RW_HEADS, RW_HEAD, RW_HEAD), F32)
    y_c, s_c = rwkv_bidirectional(prep_c, (zero, zero))
    y_x, _ = rwkv_bidirectional(prep_x, s_c)
    out_x = rwkv_output(prep_x, y_x, r_k, lnx_g, lnx_b, w_out)
    out_c = rwkv_output(prep_c, y_c, r_k, lnx_g, lnx_b, w_out) if need_ctx else None
    return out_x, out_c


def setup_inputs(seed: int = 0) -> dict:
    key = jax.random.key(seed)
    ks = iter(jax.random.split(key, 48))
    D = D_MODEL

    def nrm(shape, s):
        return s * jax.random.normal(next(ks), shape, F32)

    x = nrm((BATCH, SEQ, D), 1.0)
    c = nrm((BATCH, D), 1.0)
    ctx = nrm((BATCH, CTX_LEN, D), 1.0)
    c_ctx = nrm((D,), 1.0)
    ada_w = nrm((DEPTH, D, 3 * D), 0.5 * D ** -0.5)
    ada_b = jnp.concatenate([nrm((DEPTH, 2 * D), 0.02), 1.0 + nrm((DEPTH, D), 0.02)], axis=-1)
    norm_g = 1.0 + nrm((DEPTH, D), 0.02)
    final_g = 1.0 + nrm((D,), 0.02)
    ret_w_in = nrm((N_RET, D, 2 * RET_QK_WIDTH + 2 * RET_WIDTH), D ** -0.5)
    gamma = 1.0 - 2.0 ** (-5.0 - jnp.arange(RET_HEADS, dtype=F32))
    ret_decay = (jnp.log(gamma) - jnp.log1p(-gamma)) + nrm((N_RET, 2, RET_HEADS), 0.1)
    ret_w_out = nrm((N_RET, RET_WIDTH, D), RET_WIDTH ** -0.5)
    gm_w_in = nrm((N_GM, D, 3 * GM_WIDTH), D ** -0.5)
    gm_vnorm_g = 1.0 + nrm((N_GM, GM_WIDTH), 0.02)
    gm_w_s = nrm((N_GM, GM_GROUPS, CHUNK, CHUNK), CHUNK ** -0.5)
    gm_b_s = 1.0 + nrm((N_GM, GM_GROUPS, CHUNK), 0.02)
    gm_w_out = nrm((N_GM, GM_WIDTH, D), GM_WIDTH ** -0.5)
    rw_mu = jax.random.uniform(next(ks), (N_RW, 6, D), F32)
    rw_w_rkvg = nrm((N_RW, 4, D, RW_WIDTH), D ** -0.5)
    rw_w0 = jnp.linspace(-6.0, -1.0, RW_WIDTH, dtype=F32) + nrm((N_RW, 2, RW_WIDTH), 0.1)
    rw_w1 = nrm((N_RW, 2, D, RW_LORA), D ** -0.5)
    rw_w2 = nrm((N_RW, 2, RW_LORA, RW_WIDTH), 0.1 * RW_LORA ** -0.5)
    rw_a0 = nrm((N_RW, 2, RW_WIDTH), 0.1)
    rw_a1 = nrm((N_RW, 2, D, RW_LORA), D ** -0.5)
    rw_a2 = nrm((N_RW, 2, RW_LORA, RW_WIDTH), 0.1 * RW_LORA ** -0.5)
    rw_k_k = 0.85 + nrm((N_RW, RW_WIDTH), 0.02)
    rw_k_a = 1.0 + nrm((N_RW, RW_WIDTH), 0.02)
    rw_r_k = nrm((N_RW, RW_HEADS, RW_HEAD), 0.1)
    rw_lnx_g = 1.0 + nrm((N_RW, RW_WIDTH), 0.02)
    rw_lnx_b = nrm((N_RW, RW_WIDTH), 0.02)
    rw_w_out = nrm((N_RW, RW_WIDTH, D), RW_WIDTH ** -0.5)
    return {'x': x, 'c': c, 'ctx': ctx, 'c_ctx': c_ctx,
            'ada_w': ada_w, 'ada_b': ada_b, 'norm_g': norm_g, 'final_g': final_g,
            'ret_w_in': ret_w_in, 'ret_decay': ret_decay, 'ret_w_out': ret_w_out,
            'gm_w_in': gm_w_in, 'gm_vnorm_g': gm_vnorm_g, 'gm_w_s': gm_w_s, 'gm_b_s': gm_b_s, 'gm_w_out': gm_w_out,
            'rw_mu': rw_mu, 'rw_w_rkvg': rw_w_rkvg, 'rw_w0': rw_w0, 'rw_w1': rw_w1, 'rw_w2': rw_w2,
            'rw_a0': rw_a0, 'rw_a1': rw_a1, 'rw_a2': rw_a2, 'rw_k_k': rw_k_k, 'rw_k_a': rw_k_a,
            'rw_r_k': rw_r_k, 'rw_lnx_g': rw_lnx_g, 'rw_lnx_b': rw_lnx_b, 'rw_w_out': rw_w_out}


def reference(x, c, ctx, c_ctx, ada_w, ada_b, norm_g, final_g,
              ret_w_in, ret_decay, ret_w_out,
              gm_w_in, gm_vnorm_g, gm_w_s, gm_b_s, gm_w_out,
              rw_mu, rw_w_rkvg, rw_w0, rw_w1, rw_w2, rw_a0, rw_a1, rw_a2,
              rw_k_k, rw_k_a, rw_r_k, rw_lnx_g, rw_lnx_b, rw_w_out):
    silu_c = jax.nn.silu(c)
    silu_cc = jax.nn.silu(c_ctx)
    for i in range(DEPTH):
        kind, j = i % N_MIXERS, i // N_MIXERS
        need_ctx = i < DEPTH - 1
        shift_x, scale_x, gate_x = jnp.split(silu_c @ ada_w[i] + ada_b[i], 3, axis=-1)
        shift_c, scale_c, gate_c = jnp.split(silu_cc @ ada_w[i] + ada_b[i], 3, axis=-1)
        hx = rmsnorm(x, norm_g[i]) * (1 + scale_x[:, None]) + shift_x[:, None]
        hc = rmsnorm(ctx, norm_g[i]) * (1 + scale_c) + shift_c
        if kind == 0:
            out_x, out_c = retention_mixer(hx, hc, ret_w_in[j], ret_decay[j], ret_w_out[j], need_ctx)
        elif kind == 1:
            out_x = gmlp_chunk_mixer(hx, gm_w_in[j], gm_vnorm_g[j], gm_w_s[j], gm_b_s[j], gm_w_out[j])
            out_c = gmlp_chunk_mixer(hc, gm_w_in[j], gm_vnorm_g[j], gm_w_s[j], gm_b_s[j], gm_w_out[j]) if need_ctx else None
        else:
            out_x, out_c = rwkv_mixer(hx, hc, rw_mu[j], rw_w_rkvg[j], rw_w0[j], rw_w1[j], rw_w2[j],
                                      rw_a0[j], rw_a1[j], rw_a2[j], rw_k_k[j], rw_k_a[j], rw_r_k[j],
                                      rw_lnx_g[j], rw_lnx_b[j], rw_w_out[j], need_ctx)
        x = x + gate_x[:, None] * out_x
        if need_ctx:
            ctx = ctx + gate_c * out_c
    return rmsnorm(x, final_g)
```

```cpp
#include <hip/hip_runtime.h>
#include <hip/hip_cooperative_groups.h>
#include <cstdio>
namespace cg = cooperative_groups;

typedef unsigned short u16;
typedef __attribute__((ext_vector_type(8))) short bf16x8;
typedef __attribute__((ext_vector_type(4))) float f32x4;
typedef __attribute__((ext_vector_type(2))) float f32x2;

constexpr int D = 1024, NBATCH = 4, SEQ = 8192, CTX = 256;
constexpr int NBR = 2, NROUND = NBATCH / NBR;
constexpr int MX = NBR * SEQ, MC = NBR * CTX, MR = MX + MC;
constexpr long SLOT = (long)MR * 1024 * 2;

constexpr long WB_RET_IN = 0;
constexpr long WB_RET_OUT = WB_RET_IN + 2L * 6144 * 1024 * 2;
constexpr long WB_GM_IN = WB_RET_OUT + 2L * 1024 * 2048 * 2;
constexpr long WB_GM_OUT = WB_GM_IN + 6144L * 1024 * 2;
constexpr long WB_GM_WS = WB_GM_OUT + 1024L * 2048 * 2;
constexpr long WB_RW_G1 = WB_GM_WS + 8L * 128 * 128 * 2;
constexpr long WB_RW_G2 = WB_RW_G1 + 4352L * 1024 * 2;
constexpr long WB_RW_OUT = WB_RW_G2 + 4L * 1024 * 64 * 2;
constexpr long WB_END = WB_RW_OUT + 1024L * 1024 * 2;
static_assert(WB_END <= 64L * 1048576, "weights region");
constexpr long OFF_MODS = 64L * 1048576;
constexpr long OFF_ROPE = OFF_MODS + 262144;
constexpr long OFF_CTXS = OFF_ROPE + 65536;
constexpr long OFF_KINV = OFF_CTXS + 4L * 1048576;
constexpr long OFF_LW = OFF_KINV + 2L * 1048576;
constexpr long OFF_BAR = 79L * 1048576;
constexpr long OFF_ROUND = 80L * 1048576;
constexpr long WS_NEED = OFF_ROUND + 12 * SLOT;

struct P {
  const float *x, *c, *ctx, *c_ctx, *ada_w, *ada_b, *norm_g, *final_g;
  const float *ret_w_in, *ret_decay, *ret_w_out;
  const float *gm_w_in, *gm_vnorm_g, *gm_w_s, *gm_b_s, *gm_w_out;
  const float *rw_mu, *rw_w_rkvg, *rw_w0, *rw_w1, *rw_w2, *rw_a0, *rw_a1, *rw_a2;
  const float *rw_k_k, *rw_k_a, *rw_r_k, *rw_lnx_g, *rw_lnx_b, *rw_w_out;
  float* out;
  char* ws;
};


#define XB_TMO      128
#define XB_XCNT(j)  (256  + 64 * (j))
#define XB_XSUB(j)  (1280 + 64 * (j))
#define XB_XGEN(j)  (2304 + 64 * (j))
#define XB_TOP      3328
#define XB_TOPGEN   3392
#define XCD_BAR_WORDS 3456
#define XB_SPIN_CAP (1u << 18)
#define LAS __attribute__((address_space(3)))
__device__ __forceinline__ unsigned xb_ld(unsigned* p)              { return __hip_atomic_load(p, __ATOMIC_RELAXED, __HIP_MEMORY_SCOPE_AGENT); }
__device__ __forceinline__ unsigned xb_add(unsigned* p, unsigned v) { return __hip_atomic_fetch_add(p, v, __ATOMIC_RELAXED, __HIP_MEMORY_SCOPE_AGENT); }
__device__ __forceinline__ unsigned xb_xcc_id() { return (unsigned)__builtin_amdgcn_s_getreg((3 << 11) | 20) & 0xFu; }
#define XB_SPIN(cond, bar) do { unsigned _sp = 0; while (cond) { __builtin_amdgcn_s_sleep(1); \
    if ((++_sp & 255u) == 0u) { if (xb_ld(&(bar)[XB_TMO])) break; if (_sp > XB_SPIN_CAP) { atomicAdd(&(bar)[XB_TMO], 1u); break; } } } } while (0)
struct XcdBarrier { unsigned* bar; unsigned x; volatile LAS unsigned* st; };
__device__ __forceinline__ XcdBarrier xcd_barrier_post(unsigned* bar, volatile LAS unsigned* st) {
    XcdBarrier b; b.bar = bar; b.x = xb_xcc_id(); b.st = st;
    if (threadIdx.x == 0) (void)xb_add(&bar[XB_XCNT(b.x)], 1u);
    return b;
}
__device__ __forceinline__ void xcd_barrier_complete(unsigned* bar, unsigned x, unsigned& nloc, unsigned& nx) {
    const unsigned G = gridDim.x * gridDim.y * gridDim.z;
    unsigned sum, cnt, mine, sp = 0u;
    for (;;) {
        sum = 0u; cnt = 0u; mine = 0u;
#pragma unroll
        for (unsigned j = 0; j < 16; ++j) { const unsigned c = xb_ld(&bar[XB_XCNT(j)]); sum += c; cnt += (c > 0u) ? 1u : 0u; mine = (j == x) ? c : mine; }
        if (sum == G) break;
        __builtin_amdgcn_s_sleep(1);
        if ((++sp & 255u) == 0u) { if (xb_ld(&bar[XB_TMO])) break; if (sp > XB_SPIN_CAP) { atomicAdd(&bar[XB_TMO], 1u); break; } }
    }
    nloc = mine > 0u ? mine : 1u; nx = cnt > 0u ? cnt : 1u;
}
__device__ __forceinline__ void xcd_barrier(const XcdBarrier& b) {
    asm volatile("s_waitcnt vmcnt(0)" ::: "memory");
    __syncthreads();
    if (threadIdx.x == 0) {
        unsigned* bar = b.bar;
        __builtin_amdgcn_s_waitcnt(0);
        unsigned nloc = b.st[0], nx = b.st[1];
        if (nloc == 0u) { xcd_barrier_complete(bar, b.x, nloc, nx); b.st[0] = nloc; b.st[1] = nx; }
        const unsigned old = xb_add(&bar[XB_XSUB(b.x)], 1u);
        const unsigned gen = old / nloc;
        if (old + 1u == (gen + 1u) * nloc) {
            __builtin_amdgcn_fence(__ATOMIC_RELEASE, "agent");
            asm volatile("s_waitcnt vmcnt(0)" ::: "memory");
            const unsigned og = xb_add(&bar[XB_TOP], 1u);
            const unsigned tg = og / nx;
            if (og + 1u == (tg + 1u) * nx) xb_add(&bar[XB_TOPGEN], 1u);
            else XB_SPIN(xb_ld(&bar[XB_TOPGEN]) == tg, bar);
            __builtin_amdgcn_fence(__ATOMIC_ACQUIRE, "agent");
            xb_add(&bar[XB_XGEN(b.x)], 1u);
            asm volatile("s_waitcnt vmcnt(0)" ::: "memory");
        } else {
            XB_SPIN(xb_ld(&bar[XB_XGEN(b.x)]) == gen, bar);
            __builtin_amdgcn_fence(__ATOMIC_ACQUIRE, "agent");
            asm volatile("s_waitcnt vmcnt(0)" ::: "memory");
        }
    }
    __syncthreads();
}

__device__ __forceinline__ float bf2f(u16 h) { return __uint_as_float(((unsigned)h) << 16); }
typedef __attribute__((ext_vector_type(2))) float f32x2_;
typedef __attribute__((ext_vector_type(2))) __bf16 bf16x2_;
__device__ __forceinline__ u16 f2bf(float f) { __bf16 b = (__bf16)f; return __builtin_bit_cast(u16, b); }
__device__ __forceinline__ ushort4 pack4(float a, float b, float c, float d) {
  f32x2_ lo = {a, b}, hi = {c, d};
  unsigned l = __builtin_bit_cast(unsigned, __builtin_convertvector(lo, bf16x2_));
  unsigned h = __builtin_bit_cast(unsigned, __builtin_convertvector(hi, bf16x2_));
  return make_ushort4((u16)(l & 0xffffu), (u16)(l >> 16), (u16)(h & 0xffffu), (u16)(h >> 16));
}
__device__ __forceinline__ int opaque_v(int x) { asm volatile("" : "+v"(x)); return x; }
__device__ __forceinline__ int opaque_s(int x) { asm volatile("" : "+s"(x)); return x; }
__device__ __forceinline__ float fexp2(float x) { return __builtin_amdgcn_exp2f(x); }
__device__ __forceinline__ float siluf(float x) { return x * __builtin_amdgcn_rcpf(1.f + __expf(-x)); }
__device__ __forceinline__ float sigm(float x) { return __builtin_amdgcn_rcpf(1.f + __expf(-x)); }
#define LD8F(dst, ptr) { float4 a_ = *(const float4*)(ptr), b_ = *(const float4*)((ptr) + 4); \
  dst[0] = a_.x; dst[1] = a_.y; dst[2] = a_.z; dst[3] = a_.w; dst[4] = b_.x; dst[5] = b_.y; dst[6] = b_.z; dst[7] = b_.w; }
__device__ __forceinline__ float wave_sum(float v) {
#pragma unroll
  for (int o = 32; o > 0; o >>= 1) v += __shfl_xor(v, o);
  return v;
}

struct LdPlain {
  const u16* base; long ld;
  __device__ __forceinline__ bf16x8 get(int r, int k) const { return *(const bf16x8*)(base + (long)r * ld + k); }
};

template <bool SW, class AL, class BL>
__device__ __forceinline__ void gemm_core(const AL& al, const BL& bl, int nk32, u16* smem, f32x4 (&acc)[4][4], int tid) {
  const int nk = nk32 >> 1;
  const int lane = tid & 63, wid = tid >> 6, wr = wid >> 1, wc = wid & 1, fr = lane & 15, fq = lane >> 4;
  u16* sA = smem;
  u16* sB = smem + 16384;
  const int r0 = tid >> 3, c8 = tid & 7, kc = c8 * 8;
  const int wo = r0 * 64 + ((c8 ^ ((r0 >> 1) & 7)) * 8);
  const int sw = (fr >> 1) & 7;
  const int rs0 = ((fq) ^ sw) * 8, rs1 = ((4 + fq) ^ sw) * 8;
  const int ra_off = (wr * 64 + fr) * 64;
  const int rb_off = (wc * 64 + fr) * 64;
#pragma unroll
  for (int m = 0; m < 4; m++)
#pragma unroll
    for (int n = 0; n < 4; n++) acc[m][n] = (f32x4){0.f, 0.f, 0.f, 0.f};
  bf16x8 ga[4], gb[4];
#pragma unroll
  for (int i = 0; i < 4; i++) { ga[i] = al.get(r0 + 32 * i, kc); gb[i] = bl.get(r0 + 32 * i, kc); }
#pragma unroll
  for (int i = 0; i < 4; i++) { *(bf16x8*)(sA + wo + i * 2048) = ga[i]; *(bf16x8*)(sB + wo + i * 2048) = gb[i]; }
  __syncthreads();
  for (int kt = 0; kt < nk; kt++) {
    const int cur = kt & 1;
    const bool more = (kt + 1 < nk);
    if (more) {
      const int k = (kt + 1) * 64 + kc;
#pragma unroll
      for (int i = 0; i < 4; i++) { ga[i] = al.get(r0 + 32 * i, k); gb[i] = bl.get(r0 + 32 * i, k); }
    }
    const u16* cA = sA + cur * 8192 + ra_off;
    const u16* cB = sB + cur * 8192 + rb_off;
#pragma unroll
    for (int kk = 0; kk < 2; kk++) {
      const int rs = kk ? rs1 : rs0;
      bf16x8 At[4], Bt[4];
#pragma unroll
      for (int m = 0; m < 4; m++) At[m] = *(const bf16x8*)(cA + m * 1024 + rs);
#pragma unroll
      for (int n = 0; n < 4; n++) Bt[n] = *(const bf16x8*)(cB + n * 1024 + rs);
#pragma unroll
      for (int m = 0; m < 4; m++)
#pragma unroll
        for (int n = 0; n < 4; n++)
          acc[m][n] = SW ? __builtin_amdgcn_mfma_f32_16x16x32_bf16(Bt[n], At[m], acc[m][n], 0, 0, 0)
                         : __builtin_amdgcn_mfma_f32_16x16x32_bf16(At[m], Bt[n], acc[m][n], 0, 0, 0);
    }
    if (more) {
      u16* nA = sA + (cur ^ 1) * 8192 + wo;
      u16* nB = sB + (cur ^ 1) * 8192 + wo;
#pragma unroll
      for (int i = 0; i < 4; i++) { *(bf16x8*)(nA + i * 2048) = ga[i]; *(bf16x8*)(nB + i * 2048) = gb[i]; }
    }
    __syncthreads();
  }
}

template <bool SW>
__device__ __forceinline__ void gemm_core_plain(const u16* Abase, long lda, const u16* Bbase, long ldb, int nk32, u16* smem,
                                                f32x4 (&acc)[4][4], int tid, bool zero = true) {
  const int nk = nk32 >> 1;
  const int lane = tid & 63, wid = tid >> 6, wr = wid >> 1, wc = wid & 1, fr = lane & 15, fq = lane >> 4;
  u16* sA = smem;
  u16* sB = smem + 16384;
  const int r0 = tid >> 3, c8 = tid & 7;
  const int kc = (c8 ^ ((r0 >> 1) & 7)) * 8;
  const int sw = (fr >> 1) & 7;
  const int rs0 = ((fq) ^ sw) * 8, rs1 = ((4 + fq) ^ sw) * 8;
  const int ra_off = (wr * 64 + fr) * 64;
  const int rb_off = (wc * 64 + fr) * 64;
  const u16* pa = Abase + (long)r0 * lda + kc;
  const u16* pb = Bbase + (long)r0 * ldb + kc;
  const long sa32 = 32 * lda, sb32 = 32 * ldb;
  if (zero) {
#pragma unroll
    for (int m = 0; m < 4; m++)
#pragma unroll
      for (int n = 0; n < 4; n++) acc[m][n] = (f32x4){0.f, 0.f, 0.f, 0.f};
  }
#define GP_STAGE(BUF, T)                                                                         \
  {                                                                                              \
    const u16* qa = pa + (long)(T) * 64; const u16* qb = pb + (long)(T) * 64;                    \
    char* la = (char*)(sA + (BUF) * 8192) + tid * 16; char* lb = (char*)(sB + (BUF) * 8192) + tid * 16; \
    _Pragma("unroll") for (int i = 0; i < 4; i++) {                                              \
      __builtin_amdgcn_global_load_lds((const unsigned*)(qa + i * sa32), (unsigned*)(la + i * 4096), 16, 0, 0); \
      __builtin_amdgcn_global_load_lds((const unsigned*)(qb + i * sb32), (unsigned*)(lb + i * 4096), 16, 0, 0); \
    }                                                                                            \
  }
  GP_STAGE(0, 0)
  asm volatile("s_waitcnt vmcnt(0)" ::: "memory");
  __syncthreads();
  for (int kt = 0; kt < nk; kt++) {
    const int cur = kt & 1;
    if (kt + 1 < nk) GP_STAGE(cur ^ 1, kt + 1)
    const u16* cA = sA + cur * 8192 + ra_off;
    const u16* cB = sB + cur * 8192 + rb_off;
#pragma unroll
    for (int kk = 0; kk < 2; kk++) {
      const int rs = kk ? rs1 : rs0;
      bf16x8 At[4], Bt[4];
#pragma unroll
      for (int m = 0; m < 4; m++) At[m] = *(const bf16x8*)(cA + m * 1024 + rs);
#pragma unroll
      for (int n = 0; n < 4; n++) Bt[n] = *(const bf16x8*)(cB + n * 1024 + rs);
      __builtin_amdgcn_s_setprio(1);
#pragma unroll
      for (int m = 0; m < 4; m++)
#pragma unroll
        for (int n = 0; n < 4; n++)
          acc[m][n] = SW ? __builtin_amdgcn_mfma_f32_16x16x32_bf16(Bt[n], At[m], acc[m][n], 0, 0, 0)
                         : __builtin_amdgcn_mfma_f32_16x16x32_bf16(At[m], Bt[n], acc[m][n], 0, 0, 0);
      __builtin_amdgcn_s_setprio(0);
    }
    asm volatile("s_waitcnt vmcnt(0)" ::: "memory");
    __syncthreads();
  }
#undef GP_STAGE
}

#define GEMM_IDS \
  bid = opaque_s(bid); \
  const int tid = opaque_v(threadIdx.x), lane = tid & 63, wid = tid >> 6, wr = wid >> 1, wc = wid & 1, fr = lane & 15, fq = lane >> 4; \
  (void)tid; (void)lane; (void)wid; (void)wr; (void)wc; (void)fr; (void)fq;

__device__ __forceinline__ void tile_map(int L, int ntiles, int MT, int NT, int& tm, int& tn) {
  const int per = ntiles >> 3;
  const int t = (L & 7) * per + (L >> 3);
  const int grp = 8 * NT;
  const int g = t / grp, r = t - g * grp;
  const int rem = MT - g * 8;
  const int gsz = rem < 8 ? rem : 8;
  tm = g * 8 + r % gsz; tn = r / gsz;
}

__device__ __forceinline__ int band_map(int L, int nfull) {
  return (L < nfull) ? ((L & 7) * (nfull >> 3) + (L >> 3)) : L;
}

struct RowInfo { int is_ctx, b, t0; long srow0; };
__device__ __forceinline__ RowInfo row_info(int r, int m0) {
  RowInfo ri;
  if (m0 < MX) { int bl = m0 / SEQ; ri.is_ctx = 0; ri.t0 = m0 % SEQ; ri.b = r * NBR + bl; ri.srow0 = (long)ri.b * SEQ + ri.t0; }
  else { int mc = m0 - MX; int bl = mc / CTX; ri.is_ctx = 1; ri.t0 = mc % CTX; ri.b = r * NBR + bl; ri.srow0 = (long)ri.b * CTX + ri.t0; }
  return ri;
}

__device__ __forceinline__ void phase_mods(const P& p, int bid, int nb, float* smf) {
  float* sc = smf;
  float* red = smf + 5120;
  bid = opaque_s(bid);
  const int tid = opaque_v(threadIdx.x);
  if (bid >= 192) return;
  for (int i = tid; i < 5120; i += 256) {
    int s = i >> 10, k = i & 1023;
    float v = s < 4 ? p.c[s * 1024 + k] : p.c_ctx[k];
    sc[i] = v / (1.f + expf(-v));
  }
  __syncthreads();
  float* mods = (float*)(p.ws + OFF_MODS);
  for (int task = bid; task < 192; task += nb) {
    int layer = task / 48, n0 = (task % 48) * 64;
    int col = tid & 63, kg = tid >> 6;
    const float* w = p.ada_w + (long)layer * 1024 * 3072 + n0 + col;
    float a0 = 0, a1 = 0, a2 = 0, a3 = 0, a4 = 0;
#pragma unroll 8
    for (int k = kg * 256; k < kg * 256 + 256; k++) {
      float wv = w[(long)k * 3072];
      a0 += sc[k] * wv; a1 += sc[1024 + k] * wv; a2 += sc[2048 + k] * wv; a3 += sc[3072 + k] * wv; a4 += sc[4096 + k] * wv;
    }
    red[(kg * 5 + 0) * 64 + col] = a0; red[(kg * 5 + 1) * 64 + col] = a1; red[(kg * 5 + 2) * 64 + col] = a2;
    red[(kg * 5 + 3) * 64 + col] = a3; red[(kg * 5 + 4) * 64 + col] = a4;
    __syncthreads();
    if (tid < 64) {
      float bb = p.ada_b[layer * 3072 + n0 + tid];
#pragma unroll
      for (int s = 0; s < 5; s++) {
        float v = red[(0 * 5 + s) * 64 + tid] + red[(1 * 5 + s) * 64 + tid] + red[(2 * 5 + s) * 64 + tid] + red[(3 * 5 + s) * 64 + tid];
        mods[(layer * 5 + s) * 3072 + n0 + tid] = v + bb;
      }
    }
    __syncthreads();
  }
}

__device__ __forceinline__ int perm_col(int np) {
  int region = np >> 10, h = (np & 1023) >> 8, c256 = np & 255;
  int tau = c256 >> 7, c = c256 & 127, wcx = c >> 6, s = (c & 63) >> 4, f = c & 15;
  int pidx = tau * 64 + wcx * 32 + (s >> 1) * 16 + f;
  int d = pidx + (s & 1) * 128;
  return region * 1024 + h * 256 + d;
}

__device__ __forceinline__ void tr_tiles(const float* src, int K, int N, u16* dst, int perm, int bid, int nb, int& rot, float* tile) {
  const int tn = N / 64, nt = (K / 64) * tn;
  bid = opaque_s(bid);
  const int tid = opaque_v(threadIdx.x), c = tid & 63, rr = tid >> 6;
  for (int t = (bid + nb - (rot % nb)) % nb; t < nt; t += nb) {
    int k0 = (t / tn) * 64, n0 = (t % tn) * 64;
    int nsrc = n0 + c;
    if (perm && nsrc < 2048) nsrc = perm_col(nsrc);
    float ld[16];
#pragma unroll
    for (int i = 0; i < 16; i++) ld[i] = src[(long)(k0 + rr + i * 4) * N + nsrc];
#pragma unroll
    for (int i = 0; i < 16; i++) tile[(rr + i * 4) * 65 + c] = ld[i];
    __syncthreads();
    {
      const int nn = tid >> 2, kq = (tid & 3) * 16;
      bf16x8 o0, o1;
#pragma unroll
      for (int j = 0; j < 8; j++) { o0[j] = (short)f2bf(tile[(kq + j) * 65 + nn]); o1[j] = (short)f2bf(tile[(kq + 8 + j) * 65 + nn]); }
      u16* dp = dst + (long)(n0 + nn) * K + k0 + kq;
      *(bf16x8*)dp = o0; *(bf16x8*)(dp + 8) = o1;
    }
    __syncthreads();
  }
  rot += nt;
}

struct TrDesc { const float* src; u16* dst; int K, N, perm; };
__device__ __forceinline__ TrDesc tr_desc(const P& p, int t) {
  char* ws = p.ws;
  TrDesc d;
  d.perm = 0;
  if (t < 2) { d.src = p.ret_w_in + (long)t * 1024 * 6144; d.dst = (u16*)(ws + WB_RET_IN) + (long)t * 6144 * 1024; d.K = 1024; d.N = 6144; d.perm = 1; }
  else if (t < 4) { int j = t - 2; d.src = p.ret_w_out + (long)j * 2048 * 1024; d.dst = (u16*)(ws + WB_RET_OUT) + (long)j * 1024 * 2048; d.K = 2048; d.N = 1024; }
  else if (t == 4) { d.src = p.gm_w_in; d.dst = (u16*)(ws + WB_GM_IN); d.K = 1024; d.N = 6144; }
  else if (t == 5) { d.src = p.gm_w_out; d.dst = (u16*)(ws + WB_GM_OUT); d.K = 2048; d.N = 1024; }
  else if (t < 10) { int i = t - 6; d.src = p.rw_w_rkvg + (long)i * 1024 * 1024; d.dst = (u16*)(ws + WB_RW_G1) + (long)i * 1024 * 1024; d.K = 1024; d.N = 1024; }
  else if (t < 12) { int i = t - 10; d.src = p.rw_w1 + (long)i * 1024 * 64; d.dst = (u16*)(ws + WB_RW_G1) + (long)(4096 + 64 * i) * 1024; d.K = 1024; d.N = 64; }
  else if (t < 14) { int i = t - 12; d.src = p.rw_a1 + (long)i * 1024 * 64; d.dst = (u16*)(ws + WB_RW_G1) + (long)(4224 + 64 * i) * 1024; d.K = 1024; d.N = 64; }
  else if (t < 16) { int i = t - 14; d.src = p.rw_w2 + (long)i * 64 * 1024; d.dst = (u16*)(ws + WB_RW_G2) + (long)i * 65536; d.K = 64; d.N = 1024; }
  else if (t < 18) { int i = t - 16; d.src = p.rw_a2 + (long)i * 64 * 1024; d.dst = (u16*)(ws + WB_RW_G2) + (long)(2 + i) * 65536; d.K = 64; d.N = 1024; }
  else { d.src = p.rw_w_out; d.dst = (u16*)(ws + WB_RW_OUT); d.K = 1024; d.N = 1024; }
  return d;
}

__device__ __forceinline__ void phase_weights(const P& p, int bid, int nb, float* smf) {
  int rot = 192;
  char* ws = p.ws;
#pragma unroll 1
  for (int t = 0; t < 19; t++) {
    TrDesc d = tr_desc(p, t);
    tr_tiles(d.src, d.K, d.N, d.dst, d.perm, bid, nb, rot, smf);
  }
  {
    u16* dws = (u16*)(ws + WB_GM_WS);
    for (int i = bid * 256 + threadIdx.x; i < 8 * 128 * 128; i += nb * 256) dws[i] = f2bf(p.gm_w_s[i]);
    float2* tab = (float2*)(ws + OFF_ROPE);
    for (int i = bid * 256 + threadIdx.x; i < 128 * 64; i += nb * 256) {
      int pos = i >> 6, fi = i & 63;
      float fr = (float)pow(10000.0, -(double)fi / 64.0);
      float ang = (float)pos * fr;
      tab[i] = make_float2(cosf(ang), sinf(ang));
    }
  }
}

__device__ __forceinline__ void phase_prep(const P& p, int layer, int r, const float* xsrc, const float* csrc, u16* H, int bid, int nb) {
  bid = opaque_s(bid);
  const int tid_ = opaque_v(threadIdx.x), lane = tid_ & 63, wid = tid_ >> 6;
  const float* mods = (const float*)(p.ws + OFF_MODS);
  const float* g = p.norm_g + layer * 1024;
  for (int m = bid * 4 + wid; m < MR; m += nb * 4) {
    RowInfo ri = row_info(r, m & ~127);
    const float* src = (ri.is_ctx ? csrc : xsrc) + (ri.srow0 + (m & 127)) * 1024;
    const float* md = mods + (layer * 5 + (ri.is_ctx ? 4 : ri.b)) * 3072;
    float4 v[4];
    float ss = 0.f;
#pragma unroll
    for (int i = 0; i < 4; i++) { v[i] = *(const float4*)(src + i * 256 + lane * 4); ss += v[i].x * v[i].x + v[i].y * v[i].y + v[i].z * v[i].z + v[i].w * v[i].w; }
    ss = wave_sum(ss);
    float rs = rsqrtf(ss * (1.f / 1024.f) + 1e-6f);
#pragma unroll
    for (int i = 0; i < 4; i++) {
      int k = i * 256 + lane * 4;
      float4 gg = *(const float4*)(g + k), sh = *(const float4*)(md + k), scl = *(const float4*)(md + 1024 + k);
      ushort4 o;
      o.x = f2bf(v[i].x * rs * gg.x * (1.f + scl.x) + sh.x);
      o.y = f2bf(v[i].y * rs * gg.y * (1.f + scl.y) + sh.y);
      o.z = f2bf(v[i].z * rs * gg.z * (1.f + scl.z) + sh.z);
      o.w = f2bf(v[i].w * rs * gg.w * (1.f + scl.w) + sh.w);
      *(ushort4*)(H + (long)m * 1024 + k) = o;
    }
  }
}

__device__ __forceinline__ void phase_outproj(const P& p, int layer, int r, const u16* G, int Kdim, const u16* Wt,
                              const float* xsrc, const float* csrc, float* xdst, float* cdst, int bid, int nb, u16* smem) {
  GEMM_IDS
  const float* mods = (const float*)(p.ws + OFF_MODS);
  const int ntiles = (layer == 3 ? (MX / 128) : (MR / 128)) * 8;
  for (int tile = bid; tile < ntiles; tile += nb) {
    int tm, tn; tile_map(tile, ntiles, ntiles >> 3, 8, tm, tn);
    int m0 = tm * 128, n0 = tn * 128;
    f32x4 acc[4][4];
    gemm_core_plain<true>(G + (long)m0 * Kdim, Kdim, Wt + (long)n0 * Kdim, Kdim, Kdim / 32, smem, acc, tid);
    RowInfo ri = row_info(r, m0);
    const float* gate = mods + (layer * 5 + (ri.is_ctx ? 4 : ri.b)) * 3072 + 2048;
    const float* src = (ri.is_ctx ? csrc : xsrc) + ri.srow0 * 1024;
    float* dst = (ri.is_ctx ? cdst : xdst) + ri.srow0 * 1024;
#pragma unroll
    for (int ni = 0; ni < 4; ni++) {
      int n = n0 + wc * 64 + ni * 16 + fq * 4;
      float4 gt = *(const float4*)(gate + n);
#pragma unroll
      for (int mi = 0; mi < 4; mi++) {
        int ml = wr * 64 + mi * 16 + fr;
        long o = (long)ml * 1024 + n;
        float4 sv = *(const float4*)(src + o);
        float4 ov = make_float4(sv.x + gt.x * acc[mi][ni][0], sv.y + gt.y * acc[mi][ni][1], sv.z + gt.z * acc[mi][ni][2], sv.w + gt.w * acc[mi][ni][3]);
        *(float4*)(dst + o) = ov;
      }
    }
  }
}

__device__ __forceinline__ float log2_decay(const P& p, int jl, int dir, int h) {
  float x = p.ret_decay[(jl * 2 + dir) * 4 + h];
  float ls = -log1pf(expf(-x));
  return ls * 1.4426950408889634f;
}

__device__ __forceinline__ void phase_ret_inproj(const P& p, int r, int jl, const u16* H, const u16* Wt, u16* Q, u16* Kb, u16* KTF, u16* KTB, u16* VT, u16* Z,
                                 int bid, int nb, u16* smem) {
  GEMM_IDS
  const float2* tab = (const float2*)(p.ws + OFF_ROPE);
  const int ntiles = (MR / 128) * 48;
  for (int tile = bid; tile < ntiles; tile += nb) {
    int tm, tn; tile_map(tile, ntiles, MR / 128, 48, tm, tn);
    int m0 = tm * 128, n0 = tn * 128;
    f32x4 acc[4][4];
    gemm_core_plain<false>(H + (long)m0 * 1024, 1024, Wt + (long)n0 * 1024, 1024, 32, smem, acc, tid);
    RowInfo ri = row_info(r, m0);
    if (n0 < 2048) {
      const int region = n0 >> 10;
      const int tau = (n0 & 255) >> 7;
      const int cbase = (n0 & 1023) + wc * 64;
      u16* dstb = region ? Kb : Q;
      const float scl = region ? 0.0625f : 1.f;
      const int hh = (n0 & 1023) >> 8;
      const float lf2k = log2_decay(p, jl, 0, hh), lb2k = log2_decay(p, jl, 1, hh);
      const int LcT = ri.is_ctx ? 256 : 512;
#pragma unroll
      for (int pr = 0; pr < 2; pr++) {
        const int pidx = tau * 64 + wc * 32 + pr * 16 + fr;
        const int c1 = cbase + (2 * pr) * 16 + fr, c2 = c1 + 16;
#pragma unroll
        for (int mi = 0; mi < 4; mi++) {
          const int mlb = wr * 64 + mi * 16 + fq * 4;
          ushort4 a, b, af, bf, ab, bb;
#define ROPE_J(J, AX, BX, FX, GX, PX, QX)                                                          \
          {                                                                                        \
            float t1 = acc[mi][2 * pr][J] * scl, t2 = acc[mi][2 * pr + 1][J] * scl;                \
            float v1 = t1, v2 = t2;                                                                \
            const int t = ri.t0 + mlb + J;                                                         \
            if (!ri.is_ctx) {                                                                      \
              float2 cs = (pidx < 64) ? tab[(t >> 6) * 64 + pidx] : tab[(t & 63) * 64 + (pidx - 64)]; \
              v1 = t1 * cs.x - t2 * cs.y;                                                          \
              v2 = t1 * cs.y + t2 * cs.x;                                                          \
            }                                                                                      \
            AX = f2bf(v1); BX = f2bf(v2);                                                          \
            long row = (long)(m0 + mlb + J) * 1024;                                                \
            dstb[row + c1] = AX;                                                                   \
            dstb[row + c2] = BX;                                                                   \
            if (region) {                                                                          \
              const int jj = ri.is_ctx ? t : (t & 511);                                            \
              const float sf = fexp2((float)(LcT - 1 - jj) * lf2k), sb = fexp2((float)jj * lb2k);  \
              FX = f2bf(v1 * sf); GX = f2bf(v2 * sf); PX = f2bf(v1 * sb); QX = f2bf(v2 * sb);      \
            }                                                                                      \
          }
          ROPE_J(0, a.x, b.x, af.x, bf.x, ab.x, bb.x) ROPE_J(1, a.y, b.y, af.y, bf.y, ab.y, bb.y)
          ROPE_J(2, a.z, b.z, af.z, bf.z, ab.z, bb.z) ROPE_J(3, a.w, b.w, af.w, bf.w, ab.w, bb.w)
#undef ROPE_J
          if (region) {
            *(ushort4*)(KTF + (long)c1 * MR + m0 + mlb) = af;
            *(ushort4*)(KTF + (long)c2 * MR + m0 + mlb) = bf;
            *(ushort4*)(KTB + (long)c1 * MR + m0 + mlb) = ab;
            *(ushort4*)(KTB + (long)c2 * MR + m0 + mlb) = bb;
          }
        }
      }
    } else if (n0 < 4096) {
#pragma unroll
      for (int mi = 0; mi < 4; mi++)
#pragma unroll
        for (int ni = 0; ni < 4; ni++) {
          int col = n0 - 2048 + wc * 64 + ni * 16 + fr;
          int mrow = m0 + wr * 64 + mi * 16 + fq * 4;
          ushort4 a = pack4(acc[mi][ni][0], acc[mi][ni][1], acc[mi][ni][2], acc[mi][ni][3]);
          *(ushort4*)(VT + (long)col * MR + mrow) = a;
        }
    } else {
#pragma unroll
      for (int mi = 0; mi < 4; mi++)
#pragma unroll
        for (int ni = 0; ni < 4; ni++)
#pragma unroll
          for (int j = 0; j < 4; j++) {
            int ml = wr * 64 + mi * 16 + fq * 4 + j;
            int col = n0 - 4096 + wc * 64 + ni * 16 + fr;
            Z[(long)(m0 + ml) * 2048 + col] = f2bf(acc[mi][ni][j]);
          }
    }
  }
}


struct LdKtDecay {
  const u16* base; float l2; int dir; int Lc; float rstep;
  __device__ __forceinline__ bf16x8 get(int r, int k) const {
    bf16x8 v = *(const bf16x8*)(base + (long)r * MR + k);
    bf16x8 o;
    float f = exp2f((dir ? (float)k : (float)(Lc - 1 - k)) * l2);
#pragma unroll
    for (int i = 0; i < 8; i++) {
      o[i] = (short)f2bf(bf2f((u16)v[i]) * f);
      f *= rstep;
    }
    return o;
  }
};

__device__ __forceinline__ void phase_ret_state(const P& p, int jl, const u16* KTF, const u16* KTB, const u16* VT, u16* ST, int bid, int nb, u16* smem) {
  GEMM_IDS
  const int ntiles = NBR * 4 * 2 * 128;
  for (int tile = bid; tile < ntiles; tile += nb) {
    const int tl = band_map(tile, ntiles);
    int grp = tl >> 7, tt = tl & 127;
    int dir = grp & 1, h = (grp >> 1) & 3, bl = grp >> 3;
    int slot = tt >> 3, tm = (tt & 7) >> 1, tn = tt & 1;
    int cx;
    if (dir == 0) cx = (slot == 0) ? 16 : slot - 1; else cx = (slot == 15) ? 16 : slot + 1;
    int Lc = (cx == 16) ? 256 : 512;
    int tok0 = (cx == 16) ? (MX + bl * CTX) : (bl * SEQ + cx * 512);
    f32x4 acc[4][4];
    gemm_core_plain<true>(VT + (long)(h * 512 + tm * 128) * MR + tok0, MR,
                          (dir ? KTB : KTF) + (long)(h * 256 + tn * 128) * MR + tok0, MR, Lc / 32, smem, acc, tid);
    u16* dst = ST + ((long)(((bl * 4 + h) * 2 + dir) * 16 + slot)) * 131072;
#pragma unroll
    for (int mi = 0; mi < 4; mi++)
#pragma unroll
      for (int ni = 0; ni < 4; ni++) {
        int dv = tm * 128 + wr * 64 + mi * 16 + fr;
        int dk = tn * 128 + wc * 64 + ni * 16 + fq * 4;
        ushort4 a = pack4(acc[mi][ni][0], acc[mi][ni][1], acc[mi][ni][2], acc[mi][ni][3]);
        *(ushort4*)(dst + dv * 256 + dk) = a;
      }
  }
}

__device__ __forceinline__ void phase_ret_scan(const P& p, int jl, u16* ST, int bid, int nb) {
  const int ntask = NBR * 4 * 2 * 16384;
  for (int task = opaque_s(bid) * 256 + opaque_v(threadIdx.x); task < ntask; task += nb * 256) {
    int grp = task >> 14, e8 = (task & 16383) * 8;
    int dir = grp & 1, h = (grp >> 1) & 3;
    float cd = exp2f(512.f * log2_decay(p, jl, dir, h));
    u16* base = ST + (long)grp * 16 * 131072 + e8;
    const long first = dir ? 15L * 131072 : 0L, step = dir ? -131072L : 131072L;
    bf16x8 v[16];
#pragma unroll
    for (int i = 0; i < 16; i++) v[i] = *(const bf16x8*)(base + first + i * step);
    float cur[8];
#pragma unroll
    for (int e = 0; e < 8; e++) cur[e] = bf2f((u16)v[0][e]);
#pragma unroll
    for (int i = 1; i < 16; i++) {
      bf16x8 o;
#pragma unroll
      for (int e = 0; e < 8; e++) { cur[e] = cur[e] * cd + bf2f((u16)v[i][e]); o[e] = (short)f2bf(cur[e]); }
      *(bf16x8*)(base + first + i * step) = o;
    }
  }
}

constexpr long P_PER_BH = 16L * 512 * 512 + 256 * 256;

__device__ __forceinline__ void phase_ret_scores(const P& p, int jl, const u16* Q, const u16* Kb, u16* PB, int bid, int nb, u16* smem) {
  GEMM_IDS
  const int ntiles = NBR * 4 * 260;
  for (int tile = bid; tile < ntiles; tile += nb) {
    int tb, tt;
    const int tl = band_map(tile, NBR * 4 * 256);
    if (tl < NBR * 4 * 256) { tb = tl >> 8; tt = tl & 255; } else { int idx = tl - NBR * 4 * 256; tb = idx >> 2; tt = 256 + (idx & 3); }
    int bl = tb >> 2, h = tb & 3;
    int cx, ti, tj, Lc;
    if (tt < 256) { cx = tt >> 4; ti = (tt & 15) >> 2; tj = tt & 3; Lc = 512; }
    else { cx = 16; ti = (tt - 256) >> 1; tj = (tt - 256) & 1; Lc = 256; }
    int tok0 = (cx == 16) ? (MX + bl * CTX) : (bl * SEQ + cx * 512);
    f32x4 acc[4][4];
    gemm_core_plain<true>(Q + (long)(tok0 + ti * 128) * 1024 + h * 256, 1024, Kb + (long)(tok0 + tj * 128) * 1024 + h * 256, 1024, 8, smem, acc, tid);
    float lf2 = log2_decay(p, jl, 0, h), lb2 = log2_decay(p, jl, 1, h);
    u16* dst = PB + (long)tb * P_PER_BH + (long)cx * 262144;
#pragma unroll
    for (int mi = 0; mi < 4; mi++)
#pragma unroll
      for (int ni = 0; ni < 4; ni++) {
        int i = ti * 128 + wr * 64 + mi * 16 + fr;
        int jx0 = tj * 128 + wc * 64 + ni * 16 + fq * 4;
        u16 o4[4];
#pragma unroll
        for (int j = 0; j < 4; j++) {
          int d = i - (jx0 + j);
          float mk = (d >= 0 ? fexp2((float)d * lf2) : 0.f) + (d <= 0 ? fexp2((float)(-d) * lb2) : 0.f);
          o4[j] = f2bf(acc[mi][ni][j] * mk);
        }
        *(ushort4*)(dst + (long)i * Lc + jx0) = make_ushort4(o4[0], o4[1], o4[2], o4[3]);
      }
  }
}

struct LdOA {
  const u16* Pp; int Lc; const u16* q; int i0; float lf2, lb2;
  __device__ __forceinline__ bf16x8 get(int r, int k) const {
    if (k < Lc) return *(const bf16x8*)(Pp + (long)r * Lc + k);
    int kk = k - Lc; int seg = kk >> 8, dk = kk & 255; int i = i0 + r;
    float sc = seg == 0 ? exp2f((float)(i + 1) * lf2) : exp2f((float)(Lc - i) * lb2);
    bf16x8 v = *(const bf16x8*)(q + (long)r * 1024 + dk);
    bf16x8 o;
#pragma unroll
    for (int e = 0; e < 8; e++) o[e] = (short)f2bf(bf2f((u16)v[e]) * sc);
    return o;
  }
};
struct LdOB {
  const u16* vt; const u16* sf; const u16* sb; int Lc;
  __device__ __forceinline__ bf16x8 get(int r, int k) const {
    if (k < Lc) return *(const bf16x8*)(vt + (long)r * MR + k);
    int kk = k - Lc;
    if (kk < 256) return *(const bf16x8*)(sf + r * 256 + kk);
    return *(const bf16x8*)(sb + r * 256 + (kk - 256));
  }
};

__device__ __forceinline__ void phase_ret_o(const P& p, int jl, const u16* Q, const u16* VT, const u16* PB, const u16* ST, u16* O, int bid, int nb, u16* smem) {
  GEMM_IDS
  const int ntiles = NBR * 4 * 264;
  for (int tile = bid; tile < ntiles; tile += nb) {
    int tb, tt;
    const int tl = band_map(tile, NBR * 4 * 256);
    if (tl < NBR * 4 * 256) { tb = tl >> 8; tt = tl & 255; } else { int idx = tl - NBR * 4 * 256; tb = idx >> 3; tt = 256 + (idx & 7); }
    int bl = tb >> 2, h = tb & 3;
    int cx, ti, tn, Lc;
    if (tt < 256) { cx = tt >> 4; ti = (tt & 15) >> 2; tn = tt & 3; Lc = 512; }
    else { cx = 16; ti = (tt - 256) >> 2; tn = (tt - 256) & 3; Lc = 256; }
    int tok0 = (cx == 16) ? (MX + bl * CTX) : (bl * SEQ + cx * 512);
    f32x4 acc[4][4];
    const u16* Pp = PB + (long)tb * P_PER_BH + (long)cx * 262144 + (long)(ti * 128) * Lc;
    const u16* Vp = VT + (long)(h * 512 + tn * 128) * MR + tok0;
    {
      const float lf2 = log2_decay(p, jl, 0, h), lb2 = log2_decay(p, jl, 1, h);
      const u16* qa = Q + (long)(tok0 + ti * 128) * 1024 + h * 256;
      const int slx = (cx == 16) ? 0 : cx;
      const u16* sfp = ST + ((long)(((bl * 4 + h) * 2 + 0) * 16 + slx)) * 131072 + (long)(tn * 128) * 256;
      const u16* sbp = ST + ((long)(((bl * 4 + h) * 2 + 1) * 16 + slx)) * 131072 + (long)(tn * 128) * 256;
      const int seg0 = (cx == 16) ? 2 : 0;
#pragma unroll 1
      for (int seg = seg0; seg < 3; seg++) {
        const u16* Ap = (seg == 2) ? Pp : qa;
        const u16* Bp = (seg == 2) ? Vp : (seg == 0 ? sbp : sfp);
        const long la = (seg == 2) ? (long)Lc : 1024L, lb = (seg == 2) ? (long)MR : 256L;
        const int nk32 = (seg == 2) ? Lc / 32 : 8;
        gemm_core_plain<true>(Ap, la, Bp, lb, nk32, smem, acc, tid, seg == seg0);
        if (seg < 2) {
#pragma unroll
          for (int mi = 0; mi < 4; mi++) {
            const int i = ti * 128 + wr * 64 + mi * 16 + fr;
            const float e = (seg == 0) ? ((float)(Lc - i) * lb2 - (float)(i + 1) * lf2) : ((float)(i + 1) * lf2);
            const float sc = exp2f(e);
#pragma unroll
            for (int ni = 0; ni < 4; ni++) { acc[mi][ni][0] *= sc; acc[mi][ni][1] *= sc; acc[mi][ni][2] *= sc; acc[mi][ni][3] *= sc; }
          }
        }
      }
    }
#pragma unroll
    for (int mi = 0; mi < 4; mi++)
#pragma unroll
      for (int ni = 0; ni < 4; ni++) {
        int ml = ti * 128 + wr * 64 + mi * 16 + fr;
        int col = h * 512 + tn * 128 + wc * 64 + ni * 16 + fq * 4;
        ushort4 a = pack4(acc[mi][ni][0], acc[mi][ni][1], acc[mi][ni][2], acc[mi][ni][3]);
        *(ushort4*)(O + (long)(tok0 + ml) * 2048 + col) = a;
      }
  }
}

__device__ __forceinline__ float row16_sum(float v);
__device__ __forceinline__ void phase_ret_gate(u16* O, const u16* Z, int bid, int nb) {
  bid = opaque_s(bid);
  const int tid_ = opaque_v(threadIdx.x), lane = tid_ & 63, wid = tid_ >> 6;
  for (int m = bid * 4 + wid; m < MR; m += nb * 4) {
    long off = (long)m * 2048 + lane * 32;
    bf16x8 ov[4], zv[4];
#pragma unroll
    for (int i = 0; i < 4; i++) { ov[i] = *(const bf16x8*)(O + off + i * 8); zv[i] = *(const bf16x8*)(Z + off + i * 8); }
    float ss = 0.f;
#pragma unroll
    for (int i = 0; i < 4; i++)
#pragma unroll
      for (int e = 0; e < 8; e++) { float f = bf2f((u16)ov[i][e]); ss += f * f; }
    ss = row16_sum(ss);
    float rs = rsqrtf(ss * (1.f / 512.f) + 1e-6f);
#pragma unroll
    for (int i = 0; i < 4; i++) {
      bf16x8 o;
#pragma unroll
      for (int e = 0; e < 8; e++) o[e] = (short)f2bf(bf2f((u16)ov[i][e]) * rs * siluf(bf2f((u16)zv[i][e])));
      *(bf16x8*)(O + off + i * 8) = o;
    }
  }
}

__device__ __forceinline__ void phase_gm_inproj(const u16* H, const u16* Wt, u16* U3, int bid, int nb, u16* smem) {
  GEMM_IDS
  const int ntiles = (MR / 128) * 48;
  for (int tile = bid; tile < ntiles; tile += nb) {
    int tm, tn; tile_map(tile, ntiles, MR / 128, 48, tm, tn);
    int m0 = tm * 128, n0 = tn * 128;
    f32x4 acc[4][4];
    gemm_core_plain<true>(H + (long)m0 * 1024, 1024, Wt + (long)n0 * 1024, 1024, 32, smem, acc, tid);
    u16* dst = U3 + (long)(n0 >> 11) * MR * 2048;
#pragma unroll
    for (int mi = 0; mi < 4; mi++)
#pragma unroll
      for (int ni = 0; ni < 4; ni++) {
        int ml = wr * 64 + mi * 16 + fr;
        int col = (n0 & 2047) + wc * 64 + ni * 16 + fq * 4;
        ushort4 a = pack4(acc[mi][ni][0], acc[mi][ni][1], acc[mi][ni][2], acc[mi][ni][3]);
        *(ushort4*)(dst + (long)(m0 + ml) * 2048 + col) = a;
      }
  }
}

__device__ __forceinline__ void phase_gm_vstats(const u16* VR, float* stats, int bid, int nb) {
  bid = opaque_s(bid);
  const int tid_ = opaque_v(threadIdx.x), lane = tid_ & 63, wid = tid_ >> 6;
  for (int m = bid * 4 + wid; m < MR; m += nb * 4) {
    const u16* src = VR + (long)m * 2048;
    float s = 0.f, s2 = 0.f;
#pragma unroll
    for (int i = 0; i < 4; i++) {
      bf16x8 v = *(const bf16x8*)(src + i * 512 + lane * 8);
#pragma unroll
      for (int e = 0; e < 8; e++) { float f = bf2f((u16)v[e]); s += f; s2 += f * f; }
    }
    s = wave_sum(s); s2 = wave_sum(s2);
    float mean = s * (1.f / 2048.f);
    float var = s2 * (1.f / 2048.f) - mean * mean;
    if (lane == 0) { stats[m * 2] = mean; stats[m * 2 + 1] = rsqrtf(fmaxf(var, 0.f) + 1e-6f); }
  }
}

__device__ __forceinline__ void phase_gm_vtrans(const P& p, const u16* VR, const float* stats, u16* VT, int bid, int nb, float* smf) {
  u16* T = (u16*)smf;
  bid = opaque_s(bid);
  const int tid = opaque_v(threadIdx.x);
  for (int task = bid; task < (MR / 128) * 32; task += nb) {
    const int chunk = task >> 5, cb = task & 31;
    const int m0 = chunk * 128;
#pragma unroll
    for (int i = 0; i < 4; i++) {
      int q = tid + i * 256;
      int jj = q >> 3, c8 = (q & 7) * 8;
      bf16x8 v = *(const bf16x8*)(VR + (long)(m0 + jj) * 2048 + cb * 64 + c8);
      float2 st = *(const float2*)(stats + (m0 + jj) * 2);
      float g8[8];
      LD8F(g8, p.gm_vnorm_g + cb * 64 + c8)
#pragma unroll
      for (int e = 0; e < 8; e++) T[(c8 + e) * 136 + jj] = f2bf((bf2f((u16)v[e]) - st.x) * st.y * g8[e]);
    }
    __syncthreads();
#pragma unroll
    for (int i = 0; i < 4; i++) {
      int q = tid + i * 256;
      int ch = q >> 4, j8 = (q & 15) * 8;
      bf16x8 v = *(const bf16x8*)(T + ch * 136 + j8);
      *(bf16x8*)(VT + ((long)chunk * 2048 + cb * 64 + ch) * 128 + j8) = v;
    }
    __syncthreads();
  }
}

__device__ __forceinline__ void phase_gm_spatial(const P& p, const u16* WS, const u16* VT, u16* U, const u16* Z, int bid, int nb, u16* smem) {
  GEMM_IDS
  const int ntiles = (MR / 128) * 16;
  for (int tile = bid; tile < ntiles; tile += nb) {
    const int tl = band_map(tile, ntiles);
    int chunk = tl >> 4, g = (tl >> 1) & 7, tn = tl & 1;
    f32x4 acc[4][4];
    gemm_core_plain<true>(WS + g * 16384, 128, VT + ((long)chunk * 2048 + g * 256 + tn * 128) * 128, 128, 4, smem, acc, tid);
#pragma unroll
    for (int mi = 0; mi < 4; mi++) {
      int ml = wr * 64 + mi * 16 + fr;
      float bs = p.gm_b_s[g * 128 + ml];
#pragma unroll
      for (int ni = 0; ni < 4; ni++) {
        int col = g * 256 + tn * 128 + wc * 64 + ni * 16 + fq * 4;
        long o = (long)(chunk * 128 + ml) * 2048 + col;
        ushort4 u4 = *(const ushort4*)(U + o), z4 = *(const ushort4*)(Z + o);
        ushort4 r4;
        r4.x = f2bf(bf2f(u4.x) * (acc[mi][ni][0] + bs) * siluf(bf2f(z4.x)));
        r4.y = f2bf(bf2f(u4.y) * (acc[mi][ni][1] + bs) * siluf(bf2f(z4.y)));
        r4.z = f2bf(bf2f(u4.z) * (acc[mi][ni][2] + bs) * siluf(bf2f(z4.z)));
        r4.w = f2bf(bf2f(u4.w) * (acc[mi][ni][3] + bs) * siluf(bf2f(z4.w)));
        *(ushort4*)(U + o) = r4;
      }
    }
  }
}

struct LdMix {
  const u16* H; int m0; int is_ctx; int t0; const float* mu;
  __device__ __forceinline__ bf16x8 get(int r, int k) const {
    int m = m0 + r, t = t0 + r;
    int d; bool valid;
    if (is_ctx) { if (k < 512) { d = -1; valid = t > 0; } else { d = 1; valid = t < CTX - 1; } }
    else {
      int q = k >> 8, cl = t & 63, rw = t >> 6;
      if (q == 0) { d = -1; valid = cl > 0; } else if (q == 1) { d = 1; valid = cl < 63; }
      else if (q == 2) { d = -64; valid = rw > 0; } else { d = 64; valid = rw < 127; }
    }
    bf16x8 hv = *(const bf16x8*)(H + (long)m * 1024 + k);
    bf16x8 sv = (bf16x8){0, 0, 0, 0, 0, 0, 0, 0};
    if (valid) sv = *(const bf16x8*)(H + (long)(m + d) * 1024 + k);
    float4 mu0 = *(const float4*)(mu + k), mu1 = *(const float4*)(mu + k + 4);
    float mm[8] = {mu0.x, mu0.y, mu0.z, mu0.w, mu1.x, mu1.y, mu1.z, mu1.w};
    bf16x8 o;
#pragma unroll
    for (int e = 0; e < 8; e++) { float hf = bf2f((u16)hv[e]), sf = bf2f((u16)sv[e]); o[e] = (short)f2bf(hf + (sf - hf) * mm[e]); }
    return o;
  }
};

__device__ __forceinline__ void phase_rw_mix(const P& p, int r, const u16* H, u16* XM, int bid, int nb) {
  bid = opaque_s(bid);
  const int tid_ = opaque_v(threadIdx.x), lane = tid_ & 63, wid = tid_ >> 6;
  const long T = (long)MR * 1024;
  for (int m = bid * 4 + wid; m < MR; m += nb * 4) {
    RowInfo ri = row_info(r, m & ~127);
    const int t = ri.t0 + (m & 127);
    const int k = lane * 16;
    int d; bool valid;
    if (ri.is_ctx) { if (k < 512) { d = -1; valid = t > 0; } else { d = 1; valid = t < CTX - 1; } }
    else {
      int q = k >> 8, cl = t & 63, rw = t >> 6;
      if (q == 0) { d = -1; valid = cl > 0; } else if (q == 1) { d = 1; valid = cl < 63; }
      else if (q == 2) { d = -64; valid = rw > 0; } else { d = 64; valid = rw < 127; }
    }
    float hf[16], xf[16];
#pragma unroll
    for (int hh = 0; hh < 2; hh++) {
      bf16x8 hv = *(const bf16x8*)(H + (long)m * 1024 + k + hh * 8);
      bf16x8 sv = (bf16x8){0, 0, 0, 0, 0, 0, 0, 0};
      if (valid) sv = *(const bf16x8*)(H + (long)(m + d) * 1024 + k + hh * 8);
#pragma unroll
      for (int e = 0; e < 8; e++) { hf[hh * 8 + e] = bf2f((u16)hv[e]); xf[hh * 8 + e] = bf2f((u16)sv[e]) - hf[hh * 8 + e]; }
    }
#pragma unroll
    for (int pm = 0; pm < 6; pm++) {
      const float* mu = p.rw_mu + pm * 1024 + k;
#pragma unroll
      for (int hh = 0; hh < 2; hh++) {
        float4 m0 = *(const float4*)(mu + hh * 8), m1 = *(const float4*)(mu + hh * 8 + 4);
        float mm[8] = {m0.x, m0.y, m0.z, m0.w, m1.x, m1.y, m1.z, m1.w};
        bf16x8 o;
#pragma unroll
        for (int e = 0; e < 8; e++) o[e] = (short)f2bf(hf[hh * 8 + e] + xf[hh * 8 + e] * mm[e]);
        *(bf16x8*)(XM + pm * T + (long)m * 1024 + k + hh * 8) = o;
      }
    }
  }
}

__device__ __forceinline__ void phase_rw_gemm1(const P& p, int r, const u16* XM, const u16* Wt, u16* R4, u16* LW, int bid, int nb, u16* smem) {
  GEMM_IDS
  const int ntiles = (MR / 128) * 34;
  for (int tile = bid; tile < ntiles; tile += nb) {
    int tm, tn; tile_map(tile, ntiles, MR / 128, 34, tm, tn);
    int m0 = tm * 128, n0 = tn * 128;
    int mixp;
    if (tn < 8) mixp = 0; else if (tn < 16) mixp = 2; else if (tn < 24) mixp = 3; else if (tn < 32) mixp = 5; else if (tn == 32) mixp = 1; else mixp = 4;
    f32x4 acc[4][4];
    gemm_core_plain<true>(XM + (long)mixp * MR * 1024 + (long)m0 * 1024, 1024, Wt + (long)n0 * 1024, 1024, 32, smem, acc, tid);
    if (tn < 32) {
      u16* dst = R4 + (long)(tn >> 3) * MR * 1024;
#pragma unroll
      for (int mi = 0; mi < 4; mi++)
#pragma unroll
        for (int ni = 0; ni < 4; ni++) {
          int ml = wr * 64 + mi * 16 + fr;
          int col = (tn & 7) * 128 + wc * 64 + ni * 16 + fq * 4;
          ushort4 a = pack4(acc[mi][ni][0], acc[mi][ni][1], acc[mi][ni][2], acc[mi][ni][3]);
          *(ushort4*)(dst + (long)(m0 + ml) * 1024 + col) = a;
        }
    } else {
#pragma unroll
      for (int mi = 0; mi < 4; mi++)
#pragma unroll
        for (int ni = 0; ni < 4; ni++) {
          int ml = wr * 64 + mi * 16 + fr;
          int col = (tn - 32) * 128 + wc * 64 + ni * 16 + fq * 4;
          float v0 = acc[mi][ni][0], v1 = acc[mi][ni][1], v2 = acc[mi][ni][2], v3 = acc[mi][ni][3];
          if (tn == 32) { v0 = tanhf(v0); v1 = tanhf(v1); v2 = tanhf(v2); v3 = tanhf(v3); }
          *(ushort4*)(LW + (long)(m0 + ml) * 256 + col) = pack4(v0, v1, v2, v3);
        }
    }
  }
}

__device__ __forceinline__ void phase_rw_gemm2(const P& p, const u16* LW, const u16* W2, u16* OM2, u16* A2, const u16* Kb, float* kinv, int bid, int nb, u16* smem) {
  GEMM_IDS
  const int per = (MR / 128) * 8;
  const int ntiles = 4 * per;
  for (int tile = bid; tile < ntiles; tile += nb) {
    const int tl = band_map(tile, ntiles);
    int q = tl / per, rem = tl % per;
    int tm = rem >> 3, tn = rem & 7;
    int m0 = tm * 128, n0 = tn * 128;
    f32x4 acc[4][4];
    gemm_core_plain<true>(LW + (long)m0 * 256 + q * 64, 256, W2 + (long)q * 65536 + (long)n0 * 64, 64, 2, smem, acc, tid);
    int d = q & 1;
    const float* bias = (q < 2 ? p.rw_w0 : p.rw_a0) + d * 1024;
    u16* dst = (q < 2 ? OM2 : A2) + (long)d * MR * 1024;
#pragma unroll
    for (int ni = 0; ni < 4; ni++) {
      int n = n0 + wc * 64 + ni * 16 + fq * 4;
      float4 bb = *(const float4*)(bias + n);
#pragma unroll
      for (int mi = 0; mi < 4; mi++) {
        int ml = wr * 64 + mi * 16 + fr;
        float u0 = bb.x + acc[mi][ni][0], u1 = bb.y + acc[mi][ni][1], u2 = bb.z + acc[mi][ni][2], u3 = bb.w + acc[mi][ni][3];
        float o0, o1, o2, o3;
        if (q < 2) {
          o0 = 1.f - __expf(-0.6065306597126334f * sigm(u0)); o1 = 1.f - __expf(-0.6065306597126334f * sigm(u1));
          o2 = 1.f - __expf(-0.6065306597126334f * sigm(u2)); o3 = 1.f - __expf(-0.6065306597126334f * sigm(u3));
        } else { o0 = sigm(u0); o1 = sigm(u1); o2 = sigm(u2); o3 = sigm(u3); }
        *(ushort4*)(dst + (long)(m0 + ml) * 1024 + n) = pack4(o0, o1, o2, o3);
      }
    }
  }
  for (int m = bid * 4 + wid; m < MR; m += nb * 4) {
    const u16* src = Kb + (long)m * 1024 + lane * 16;
    bf16x8 v0 = *(const bf16x8*)src, v1 = *(const bf16x8*)(src + 8);
    float s = 0.f;
    float kk0[8], kk1[8];
    LD8F(kk0, p.rw_k_k + lane * 16) LD8F(kk1, p.rw_k_k + lane * 16 + 8)
#pragma unroll
    for (int e = 0; e < 8; e++) {
      float a = bf2f((u16)v0[e]) * kk0[e], b = bf2f((u16)v1[e]) * kk1[e];
      s += a * a + b * b;
    }
    s += __shfl_xor(s, 1); s += __shfl_xor(s, 2);
    if ((lane & 3) == 0) kinv[m * 16 + (lane >> 2)] = 1.f / fmaxf(sqrtf(s), 1e-12f);
  }
}

__device__ __forceinline__ float row16_sum(float v) {
  int x;
  x = __builtin_amdgcn_update_dpp(0, __float_as_int(v), 0xB1, 0xF, 0xF, false); v += __int_as_float(x);
  x = __builtin_amdgcn_update_dpp(0, __float_as_int(v), 0x4E, 0xF, 0xF, false); v += __int_as_float(x);
  x = __builtin_amdgcn_update_dpp(0, __float_as_int(v), 0x141, 0xF, 0xF, false); v += __int_as_float(x);
  x = __builtin_amdgcn_update_dpp(0, __float_as_int(v), 0x140, 0xF, 0xF, false); v += __int_as_float(x);
  return v;
}

constexpr int SCAN_VS = 336;
constexpr int SCAN_STEPS = CTX + SEQ;
__device__ __forceinline__ int scan_row(int step, int dir, int bl) {
  if (step < CTX) { int t = dir ? (CTX - 1 - step) : step; return MX + bl * CTX + t; }
  int t = step - CTX; t = dir ? (SEQ - 1 - t) : t; return bl * SEQ + t;
}

__device__ __forceinline__ void phase_rw_scan(const P& p, const u16* R4, const u16* OM2, const u16* A2, const float* kinv, u16* Y2, int bid, int nb, float* smf) {
  float* buf = smf;
  bid = opaque_s(bid);
  const int tid = opaque_v(threadIdx.x), lane = tid & 63, wid = tid >> 6, rl = lane >> 4, kl = lane & 15;
  const int st_t = tid >> 4, st_k4 = (tid & 15) * 4;
  const u16* Rb = R4; const u16* Kb = R4 + (long)MR * 1024; const u16* Vb = R4 + 2L * MR * 1024;
  for (int task = bid; task < NBR * 16 * 2 * 4; task += nb) {
    const int tsk = (task < 256) ? ((task & 7) * 32 + (task >> 3)) : task;
    const int rb = tsk & 3, chain = tsk >> 2, dir = chain & 1, h = (chain >> 1) & 15, bl = chain >> 5;
    const u16* OM = OM2 + (long)dir * MR * 1024; const u16* AA = A2 + (long)dir * MR * 1024;
    u16* Y = Y2 + (long)dir * MR * 1024;
    const float4 kkc = *(const float4*)(p.rw_k_k + h * 64 + st_k4), kac = *(const float4*)(p.rw_k_a + h * 64 + st_k4);
    f32x2 s01 = {0.f, 0.f}, s23 = {0.f, 0.f};
    struct StageRegs { ushort4 gk, gr, ga, go; float gki; u16 gv; };
    StageRegs RA, RB;
    auto gload = [&](int blk, StageRegs& R) {
      ushort4& gk = R.gk; ushort4& gr = R.gr; ushort4& ga = R.ga; ushort4& go = R.go; float& gki = R.gki; u16& gv = R.gv;
      int m = scan_row(blk * 16 + st_t, dir, bl);
      long off = (long)m * 1024 + h * 64 + st_k4;
      gk = *(const ushort4*)(Kb + off); gr = *(const ushort4*)(Rb + off); ga = *(const ushort4*)(AA + off); go = *(const ushort4*)(OM + off);
      gki = kinv[m * 16 + h];
      gv = Vb[(long)m * 1024 + h * 64 + rb * 16 + (tid & 15)];
    };
    auto gstore = [&](int b, const StageRegs& R) {
      const ushort4 gk = R.gk, gr = R.gr, ga = R.ga, go = R.go; const float gki = R.gki; const u16 gv = R.gv;
      float* bp = buf + b * (16 * SCAN_VS) + st_t * SCAN_VS;
      float k0 = bf2f(gk.x), k1 = bf2f(gk.y), k2 = bf2f(gk.z), k3 = bf2f(gk.w);
      float a0 = bf2f(ga.x), a1 = bf2f(ga.y), a2 = bf2f(ga.z), a3 = bf2f(ga.w);
      float q0 = k0 * kkc.x * gki, q1 = k1 * kkc.y * gki, q2 = k2 * kkc.z * gki, q3 = k3 * kkc.w * gki;
      *(float4*)(bp + 0 + st_k4) = make_float4(-q0, -q1, -q2, -q3);
      *(float4*)(bp + 64 + st_k4) = make_float4(1.f - bf2f(go.x), 1.f - bf2f(go.y), 1.f - bf2f(go.z), 1.f - bf2f(go.w));
      *(float4*)(bp + 128 + st_k4) = make_float4(q0 * a0, q1 * a1, q2 * a2, q3 * a3);
      *(float4*)(bp + 192 + st_k4) = make_float4(k0 * (1.f + (a0 - 1.f) * kac.x), k1 * (1.f + (a1 - 1.f) * kac.y),
                                                 k2 * (1.f + (a2 - 1.f) * kac.z), k3 * (1.f + (a3 - 1.f) * kac.w));
      *(float4*)(bp + 256 + st_k4) = make_float4(bf2f(gr.x), bf2f(gr.y), bf2f(gr.z), bf2f(gr.w));
      bp[320 + (tid & 15)] = bf2f(gv);
    };
    const int nblk = SCAN_STEPS / 16;
    const int yrow_off = h * 64 + rb * 16 + wid * 4 + rl;
    auto compute = [&](int blk, int cur) {
      const float* bb = buf + cur * (16 * SCAN_VS) + kl * 4;
      const float* vb = buf + cur * (16 * SCAN_VS) + 320 + wid * 4 + rl;
      float4 nk = *(const float4*)(bb), w = *(const float4*)(bb + 64), b4 = *(const float4*)(bb + 128);
      float4 kt = *(const float4*)(bb + 192), rr = *(const float4*)(bb + 256);
      float vv = vb[0];
      float yp[16];
#pragma unroll
      for (int tt = 0; tt < 16; tt++) {
        float4 nk_n, w_n, b4_n, kt_n, rr_n; float vv_n;
        if (tt + 1 < 16) {
          const float* bp = bb + (tt + 1) * SCAN_VS;
          nk_n = *(const float4*)(bp); w_n = *(const float4*)(bp + 64); b4_n = *(const float4*)(bp + 128);
          kt_n = *(const float4*)(bp + 192); rr_n = *(const float4*)(bp + 256);
          vv_n = vb[(tt + 1) * SCAN_VS];
        }
        f32x2 p2 = s01 * (f32x2){nk.x, nk.y} + s23 * (f32x2){nk.z, nk.w};
        float sa = row16_sum(p2.x + p2.y);
        const f32x2 sa2 = {sa, sa}, vv2 = {vv, vv};
        s01 = s01 * (f32x2){w.x, w.y} + sa2 * (f32x2){b4.x, b4.y} + vv2 * (f32x2){kt.x, kt.y};
        s23 = s23 * (f32x2){w.z, w.w} + sa2 * (f32x2){b4.z, b4.w} + vv2 * (f32x2){kt.z, kt.w};
        f32x2 y2 = s01 * (f32x2){rr.x, rr.y} + s23 * (f32x2){rr.z, rr.w};
        yp[tt] = y2.x + y2.y;
        if (tt + 1 < 16) { nk = nk_n; w = w_n; b4 = b4_n; kt = kt_n; rr = rr_n; vv = vv_n; }
      }
      {
        const bool gA = (kl & 8) != 0, gB = (kl & 4) != 0, gC = (kl & 2) != 0, gD = (kl & 1) != 0;
        float a8[8], a4[4], a2[2];
#pragma unroll
        for (int j = 0; j < 8; j++) {
          float keep = gA ? yp[j + 8] : yp[j], send = gA ? yp[j] : yp[j + 8];
          a8[j] = keep + __int_as_float(__builtin_amdgcn_update_dpp(0, __float_as_int(send), 0x140, 0xF, 0xF, false));
        }
#pragma unroll
        for (int j = 0; j < 4; j++) {
          float keep = gB ? a8[j + 4] : a8[j], send = gB ? a8[j] : a8[j + 4];
          a4[j] = keep + __int_as_float(__builtin_amdgcn_update_dpp(0, __float_as_int(send), 0x141, 0xF, 0xF, false));
        }
#pragma unroll
        for (int j = 0; j < 2; j++) {
          float keep = gC ? a4[j + 2] : a4[j], send = gC ? a4[j] : a4[j + 2];
          a2[j] = keep + __int_as_float(__builtin_amdgcn_update_dpp(0, __float_as_int(send), 0x4E, 0xF, 0xF, false));
        }
        float keep = gD ? a2[1] : a2[0], send = gD ? a2[0] : a2[1];
        float ysel = keep + __int_as_float(__builtin_amdgcn_update_dpp(0, __float_as_int(send), 0xB1, 0xF, 0xF, false));
        int m = scan_row(blk * 16 + kl, dir, bl);
        Y[(long)m * 1024 + yrow_off] = f2bf(ysel);
      }
    };
    gload(0, RA); gstore(0, RA); gload(1, RA);
    __syncthreads();
    for (int blk = 0; blk < nblk; blk += 2) {
      if (blk + 2 < nblk) gload(blk + 2, RB);
      compute(blk, 0);
      gstore(1, RA);
      __syncthreads();
      if (blk + 3 < nblk) gload(blk + 3, RA);
      compute(blk + 1, 1);
      if (blk + 2 < nblk) gstore(0, RB);
      __syncthreads();
    }
  }
}

__device__ __forceinline__ void phase_rw_outprep(const P& p, const u16* R4, const u16* A2, const u16* Y2, u16* G, int bid, int nb) {
  bid = opaque_s(bid);
  const int tid_ = opaque_v(threadIdx.x), lane = tid_ & 63, wid = tid_ >> 6;
  const long T = (long)MR * 1024;
  for (int m = bid * 4 + wid; m < MR; m += nb * 4) {
    long off = (long)m * 1024 + lane * 16;
    float y[16], bon = 0.f, s = 0.f;
#pragma unroll
    for (int hh = 0; hh < 2; hh++) {
      bf16x8 yf = *(const bf16x8*)(Y2 + off + hh * 8), yb = *(const bf16x8*)(Y2 + T + off + hh * 8);
      bf16x8 rv = *(const bf16x8*)(R4 + off + hh * 8), kv = *(const bf16x8*)(R4 + T + off + hh * 8);
      bf16x8 af = *(const bf16x8*)(A2 + off + hh * 8), ab = *(const bf16x8*)(A2 + T + off + hh * 8);
      float ka8[8], rk8[8];
      LD8F(ka8, p.rw_k_a + lane * 16 + hh * 8) LD8F(rk8, p.rw_r_k + lane * 16 + hh * 8)
#pragma unroll
      for (int e = 0; e < 8; e++) {
        float yy = bf2f((u16)yf[e]) + bf2f((u16)yb[e]);
        y[hh * 8 + e] = yy; s += yy;
        float ka = ka8[e], kf = bf2f((u16)kv[e]);
        float kt0 = kf * (1.f + (bf2f((u16)af[e]) - 1.f) * ka), kt1 = kf * (1.f + (bf2f((u16)ab[e]) - 1.f) * ka);
        bon += bf2f((u16)rv[e]) * (kt0 + kt1) * rk8[e];
      }
    }
    s += __shfl_xor(s, 1); s += __shfl_xor(s, 2);
    bon += __shfl_xor(bon, 1); bon += __shfl_xor(bon, 2);
    float mean = s * (1.f / 64.f);
    float vs = 0.f;
#pragma unroll
    for (int e = 0; e < 16; e++) { float dlt = y[e] - mean; vs += dlt * dlt; }
    vs += __shfl_xor(vs, 1); vs += __shfl_xor(vs, 2);
    float rs = rsqrtf(vs * (1.f / 64.f) + 64e-5f);
#pragma unroll
    for (int hh = 0; hh < 2; hh++) {
      bf16x8 vv = *(const bf16x8*)(R4 + 2 * T + off + hh * 8), zv = *(const bf16x8*)(R4 + 3 * T + off + hh * 8);
      bf16x8 o;
      float lg8[8], lb8[8];
      LD8F(lg8, p.rw_lnx_g + lane * 16 + hh * 8) LD8F(lb8, p.rw_lnx_b + lane * 16 + hh * 8)
#pragma unroll
      for (int e = 0; e < 8; e++) {
        float yn = (y[hh * 8 + e] - mean) * rs * lg8[e] + lb8[e];
        o[e] = (short)f2bf((yn + bon * bf2f((u16)vv[e])) * siluf(bf2f((u16)zv[e])));
      }
      *(bf16x8*)(G + off + hh * 8) = o;
    }
  }
}

__device__ __forceinline__ void phase_final(const P& p, int bid, int nb) {
  bid = opaque_s(bid);
  const int tid_ = opaque_v(threadIdx.x), lane = tid_ & 63, wid = tid_ >> 6;
  for (int m = bid * 4 + wid; m < NBATCH * SEQ; m += nb * 4) {
    float* row = p.out + (long)m * 1024;
    float4 v[4]; float ss = 0.f;
#pragma unroll
    for (int i = 0; i < 4; i++) { v[i] = *(const float4*)(row + i * 256 + lane * 4); ss += v[i].x * v[i].x + v[i].y * v[i].y + v[i].z * v[i].z + v[i].w * v[i].w; }
    ss = wave_sum(ss);
    float rs = rsqrtf(ss * (1.f / 1024.f) + 1e-6f);
#pragma unroll
    for (int i = 0; i < 4; i++) {
      float4 g = *(const float4*)(p.final_g + i * 256 + lane * 4);
      float4 o = make_float4(v[i].x * rs * g.x, v[i].y * rs * g.y, v[i].z * rs * g.z, v[i].w * rs * g.w);
      *(float4*)(row + i * 256 + lane * 4) = o;
    }
  }
}

__global__ void __launch_bounds__(256, 2) fwd_megakernel(P p) {
  cg::grid_group grid = cg::this_grid();
  extern __shared__ __attribute__((aligned(16))) float smf[];
  u16* smem = (u16*)smf;
  const int bid = blockIdx.x, nb = gridDim.x;
  char* ws = p.ws;
  float* ctxs = (float*)(ws + OFF_CTXS);
  char* rb = ws + OFF_ROUND;
  __shared__ uint4 xb_words;
  __shared__ __attribute__((aligned(16))) float ysel_unused[4];
  (void)ysel_unused;
  if (threadIdx.x == 0) xb_words = make_uint4(0u, 0u, 0u, 0u);
  __syncthreads();
  XcdBarrier xb = xcd_barrier_post((unsigned*)(ws + OFF_BAR), (volatile LAS unsigned*)&xb_words);

  phase_mods(p, bid, nb, smf);
  __syncthreads();
  phase_weights(p, bid, nb, smf);
  if (gridDim.y > 1) grid.sync();
  xcd_barrier(xb);
  phase_prep(p, 0, 0, p.x, p.ctx, (u16*)rb, bid, nb);
  xcd_barrier(xb);

#pragma unroll 1
  for (int layer = 0; layer < 4; layer++) {
    const int kind = layer % 3, jl = layer / 3;
    const float* xsrc = layer == 0 ? p.x : p.out;
    const float* csrc = layer == 0 ? p.ctx : ctxs;
#pragma unroll 1
    for (int r = 0; r < NROUND; r++) {
      u16* H = (u16*)rb;
#ifndef NO_RET
      if (kind == 0) {
        u16* KT = (u16*)(rb + 1 * SLOT); u16* PB = (u16*)rb;
        u16* Q = (u16*)(rb + 2 * SLOT); u16* Kb = (u16*)(rb + 3 * SLOT);
        u16* VT = (u16*)(rb + 4 * SLOT); u16* Z = (u16*)(rb + 6 * SLOT);
        u16* O = (u16*)(rb + 8 * SLOT); u16* ST = (u16*)(rb + 10 * SLOT);
        u16* KTB = (u16*)(rb + 8 * SLOT);
        phase_ret_inproj(p, r, jl, H, (const u16*)(ws + WB_RET_IN) + (long)jl * 6144 * 1024, Q, Kb, KT, KTB, VT, Z, bid, nb, smem);
        xcd_barrier(xb);
        phase_ret_state(p, jl, KT, KTB, VT, ST, bid, nb, smem);
        xcd_barrier(xb);
        phase_ret_scan(p, jl, ST, bid, nb);
        phase_ret_scores(p, jl, Q, Kb, PB, bid, nb, smem);
        xcd_barrier(xb);
        phase_ret_o(p, jl, Q, VT, PB, ST, O, bid, nb, smem);
        xcd_barrier(xb);
        phase_ret_gate(O, Z, bid, nb);
        xcd_barrier(xb);
        phase_outproj(p, layer, r, O, 2048, (const u16*)(ws + WB_RET_OUT) + (long)jl * 1024 * 2048, xsrc, csrc, p.out, ctxs, bid, nb, smem);
      }
#endif
#ifndef NO_GM
      if (kind == 1) {
        u16* U = (u16*)(rb + 1 * SLOT); u16* VR = (u16*)(rb + 3 * SLOT); u16* Z = (u16*)(rb + 5 * SLOT); u16* VT = (u16*)(rb + 7 * SLOT);
        phase_gm_inproj(H, (const u16*)(ws + WB_GM_IN), U, bid, nb, smem);
        xcd_barrier(xb);
        float* vstats = (float*)(ws + OFF_KINV);
        phase_gm_vstats(VR, vstats, bid, nb);
        xcd_barrier(xb);
        phase_gm_vtrans(p, VR, vstats, VT, bid, nb, smf);
        xcd_barrier(xb);
        phase_gm_spatial(p, (const u16*)(ws + WB_GM_WS), VT, U, Z, bid, nb, smem);
        xcd_barrier(xb);
        phase_outproj(p, layer, r, U, 2048, (const u16*)(ws + WB_GM_OUT), xsrc, csrc, p.out, ctxs, bid, nb, smem);
      }
#endif
#ifndef NO_RW
      if (kind == 2) {
        u16* R4 = (u16*)(rb + 1 * SLOT); u16* OM2 = (u16*)(rb + 5 * SLOT); u16* A2 = (u16*)(rb + 7 * SLOT); u16* Y2 = (u16*)(rb + 9 * SLOT);
        u16* LW = (u16*)(ws + OFF_LW); float* kinv = (float*)(ws + OFF_KINV);
        u16* XM = (u16*)(rb + 5 * SLOT);
        phase_rw_mix(p, r, H, XM, bid, nb);
        xcd_barrier(xb);
        phase_rw_gemm1(p, r, XM, (const u16*)(ws + WB_RW_G1), R4, LW, bid, nb, smem);
        xcd_barrier(xb);
        phase_rw_gemm2(p, LW, (const u16*)(ws + WB_RW_G2), OM2, A2, R4 + (long)MR * 1024, kinv, bid, nb, smem);
        xcd_barrier(xb);
        phase_rw_scan(p, R4, OM2, A2, kinv, Y2, bid, nb, smf);
        xcd_barrier(xb);
        u16* GW = (u16*)(rb + 11 * SLOT);
        phase_rw_outprep(p, R4, A2, Y2, GW, bid, nb);
        xcd_barrier(xb);
        phase_outproj(p, layer, r, GW, 1024, (const u16*)(ws + WB_RW_OUT), xsrc, csrc, p.out, ctxs, bid, nb, smem);
      }
#endif
      {
        int nl = layer, nr = r + 1;
        if (nr == NROUND) { nr = 0; nl = layer + 1; }
        const int skipb = (layer == 3) ? 0 : 32;
        if (nl < 4 && bid >= skipb) phase_prep(p, nl, nr, nl == 0 ? p.x : p.out, nl == 0 ? p.ctx : ctxs, H, bid - skipb, nb - skipb);
      }
      xcd_barrier(xb);
    }
  }
  phase_final(p, bid, nb);
}

extern "C" void kernel_launch(void* const* d_in, const int* in_sizes, int n_in, void* d_out, int out_size, void* d_ws,
                              size_t ws_size, hipStream_t stream) {
  static int grid_blocks = 0;
  if (!grid_blocks) {
    int dev = 0, cus = 0, per_cu = 0;
    (void)hipGetDevice(&dev);
    (void)hipDeviceGetAttribute(&cus, hipDeviceAttributeMultiprocessorCount, dev);
    (void)hipFuncSetAttribute((const void*)fwd_megakernel, hipFuncAttributeMaxDynamicSharedMemorySize, 65536);
    (void)hipOccupancyMaxActiveBlocksPerMultiprocessor(&per_cu, fwd_megakernel, 256, 65536);
    if (per_cu > 2) per_cu = 2;
    if (per_cu < 1) per_cu = 1;
    grid_blocks = cus * per_cu;
  }
  if ((size_t)WS_NEED > ws_size) fprintf(stderr, "workspace too small: need %ld have %zu\n", (long)WS_NEED, ws_size);
  P p{};
  const float** pp = (const float**)&p;
  for (int i = 0; i < 30; i++) pp[i] = (const float*)d_in[i];
  p.out = (float*)d_out;
  p.ws = (char*)d_ws;
  (void)hipMemsetAsync((char*)d_ws + OFF_BAR, 0, XCD_BAR_WORDS * 4, stream);
  void* args[] = {&p};
  hipError_t e = hipLaunchCooperativeKernel((void*)fwd_megakernel, dim3(grid_blocks), dim3(256), args, 65536, stream);
  if (e != hipSuccess) fprintf(stderr, "cooperative launch failed: %s (grid %d)\n", hipGetErrorString(e), grid_blocks);
}
```

```cpp
#include <hip/hip_runtime.h>
#include <hip/hip_cooperative_groups.h>
#include <cstdio>
namespace cg = cooperative_groups;

typedef unsigned short u16;
typedef __attribute__((ext_vector_type(8))) short bf16x8;
typedef __attribute__((ext_vector_type(4))) float f32x4;
typedef __attribute__((ext_vector_type(2))) float f32x2;

constexpr int D = 1024, NBATCH = 4, SEQ = 8192, CTX = 256;
constexpr int NBR = 2, NROUND = NBATCH / NBR;
constexpr int MX = NBR * SEQ, MC = NBR * CTX, MR = MX + MC;
constexpr long SLOT = (long)MR * 1024 * 2;

constexpr long WB_RET_IN = 0;
constexpr long WB_RET_OUT = WB_RET_IN + 2L * 6144 * 1024 * 2;
constexpr long WB_GM_IN = WB_RET_OUT + 2L * 1024 * 2048 * 2;
constexpr long WB_GM_OUT = WB_GM_IN + 6144L * 1024 * 2;
constexpr long WB_GM_WS = WB_GM_OUT + 1024L * 2048 * 2;
constexpr long WB_RW_G1 = WB_GM_WS + 8L * 128 * 128 * 2;
constexpr long WB_RW_G2 = WB_RW_G1 + 4352L * 1024 * 2;
constexpr long WB_RW_OUT = WB_RW_G2 + 4L * 1024 * 64 * 2;
constexpr long WB_END = WB_RW_OUT + 1024L * 1024 * 2;
static_assert(WB_END <= 64L * 1048576, "weights region");
constexpr long OFF_MODS = 64L * 1048576;
constexpr long OFF_ROPE = OFF_MODS + 262144;
constexpr long OFF_CTXS = OFF_ROPE + 65536;
constexpr long OFF_KINV = OFF_CTXS + 4L * 1048576;
constexpr long OFF_LW = OFF_KINV + 2L * 1048576;
constexpr long OFF_BAR = 79L * 1048576;
constexpr long OFF_ROUND = 80L * 1048576;
constexpr long WS_NEED = OFF_ROUND + 12 * SLOT;

struct P {
  const float *x, *c, *ctx, *c_ctx, *ada_w, *ada_b, *norm_g, *final_g;
  const float *ret_w_in, *ret_decay, *ret_w_out;
  const float *gm_w_in, *gm_vnorm_g, *gm_w_s, *gm_b_s, *gm_w_out;
  const float *rw_mu, *rw_w_rkvg, *rw_w0, *rw_w1, *rw_w2, *rw_a0, *rw_a1, *rw_a2;
  const float *rw_k_k, *rw_k_a, *rw_r_k, *rw_lnx_g, *rw_lnx_b, *rw_w_out;
  float* out;
  char* ws;
};


#define XB_TMO      128
#define XB_XCNT(j)  (256  + 64 * (j))
#define XB_XSUB(j)  (1280 + 64 * (j))
#define XB_XGEN(j)  (2304 + 64 * (j))
#define XB_TOP      3328
#define XB_TOPGEN   3392
#define XCD_BAR_WORDS 3456
#define XB_SPIN_CAP (1u << 18)
#define LAS __attribute__((address_space(3)))
__device__ __forceinline__ unsigned xb_ld(unsigned* p)              { return __hip_atomic_load(p, __ATOMIC_RELAXED, __HIP_MEMORY_SCOPE_AGENT); }
__device__ __forceinline__ unsigned xb_add(unsigned* p, unsigned v) { return __hip_atomic_fetch_add(p, v, __ATOMIC_RELAXED, __HIP_MEMORY_SCOPE_AGENT); }
__device__ __forceinline__ unsigned xb_xcc_id() { return (unsigned)__builtin_amdgcn_s_getreg((3 << 11) | 20) & 0xFu; }
#define XB_SPIN(cond, bar) do { unsigned _sp = 0; while (cond) { __builtin_amdgcn_s_sleep(1); \
    if ((++_sp & 255u) == 0u) { if (xb_ld(&(bar)[XB_TMO])) break; if (_sp > XB_SPIN_CAP) { atomicAdd(&(bar)[XB_TMO], 1u); break; } } } } while (0)
struct XcdBarrier { unsigned* bar; unsigned x; volatile LAS unsigned* st; };
__device__ __forceinline__ XcdBarrier xcd_barrier_post(unsigned* bar, volatile LAS unsigned* st) {
    XcdBarrier b; b.bar = bar; b.x = xb_xcc_id(); b.st = st;
    if (threadIdx.x == 0) (void)xb_add(&bar[XB_XCNT(b.x)], 1u);
    return b;
}
__device__ __forceinline__ void xcd_barrier_complete(unsigned* bar, unsigned x, unsigned& nloc, unsigned& nx) {
    const unsigned G = gridDim.x * gridDim.y * gridDim.z;
    unsigned sum, cnt, mine, sp = 0u;
    for (;;) {
        sum = 0u; cnt = 0u; mine = 0u;
#pragma unroll
        for (unsigned j = 0; j < 16; ++j) { const unsigned c = xb_ld(&bar[XB_XCNT(j)]); sum += c; cnt += (c > 0u) ? 1u : 0u; mine = (j == x) ? c : mine; }
        if (sum == G) break;
        __builtin_amdgcn_s_sleep(1);
        if ((++sp & 255u) == 0u) { if (xb_ld(&bar[XB_TMO])) break; if (sp > XB_SPIN_CAP) { atomicAdd(&bar[XB_TMO], 1u); break; } }
    }
    nloc = mine > 0u ? mine : 1u; nx = cnt > 0u ? cnt : 1u;
}
__device__ __forceinline__ void xcd_barrier(const XcdBarrier& b) {
    asm volatile("s_waitcnt vmcnt(0)" ::: "memory");
    __syncthreads();
    if (threadIdx.x == 0) {
        unsigned* bar = b.bar;
        __builtin_amdgcn_s_waitcnt(0);
        unsigned nloc = b.st[0], nx = b.st[1];
        if (nloc == 0u) { xcd_barrier_complete(bar, b.x, nloc, nx); b.st[0] = nloc; b.st[1] = nx; }
        const unsigned old = xb_add(&bar[XB_XSUB(b.x)], 1u);
        const unsigned gen = old / nloc;
        if (old + 1u == (gen + 1u) * nloc) {
            __builtin_amdgcn_fence(__ATOMIC_RELEASE, "agent");
            asm volatile("s_waitcnt vmcnt(0)" ::: "memory");
            const unsigned og = xb_add(&bar[XB_TOP], 1u);
            const unsigned tg = og / nx;
            if (og + 1u == (tg + 1u) * nx) xb_add(&bar[XB_TOPGEN], 1u);
            else XB_SPIN(xb_ld(&bar[XB_TOPGEN]) == tg, bar);
            __builtin_amdgcn_fence(__ATOMIC_ACQUIRE, "agent");
            xb_add(&bar[XB_XGEN(b.x)], 1u);
            asm volatile("s_waitcnt vmcnt(0)" ::: "memory");
        } else {
            XB_SPIN(xb_ld(&bar[XB_XGEN(b.x)]) == gen, bar);
            __builtin_amdgcn_fence(__ATOMIC_ACQUIRE, "agent");
            asm volatile("s_waitcnt vmcnt(0)" ::: "memory");
        }
    }
    __syncthreads();
}

__device__ __forceinline__ float bf2f(u16 h) { return __uint_as_float(((unsigned)h) << 16); }
typedef __attribute__((ext_vector_type(2))) float f32x2_;
typedef __attribute__((ext_vector_type(2))) __bf16 bf16x2_;
__device__ __forceinline__ u16 f2bf(float f) { __bf16 b = (__bf16)f; return __builtin_bit_cast(u16, b); }
__device__ __forceinline__ ushort4 pack4(float a, float b, float c, float d) {
  f32x2_ lo = {a, b}, hi = {c, d};
  unsigned l = __builtin_bit_cast(unsigned, __builtin_convertvector(lo, bf16x2_));
  unsigned h = __builtin_bit_cast(unsigned, __builtin_convertvector(hi, bf16x2_));
  return make_ushort4((u16)(l & 0xffffu), (u16)(l >> 16), (u16)(h & 0xffffu), (u16)(h >> 16));
}
__device__ __forceinline__ int opaque_v(int x) { asm volatile("" : "+v"(x)); return x; }
__device__ __forceinline__ int opaque_s(int x) { asm volatile("" : "+s"(x)); return x; }
__device__ __forceinline__ float fexp2(float x) { return __builtin_amdgcn_exp2f(x); }
__device__ __forceinline__ float siluf(float x) { return x * __builtin_amdgcn_rcpf(1.f + __expf(-x)); }
__device__ __forceinline__ float sigm(float x) { return __builtin_amdgcn_rcpf(1.f + __expf(-x)); }
#define LD8F(dst, ptr) { float4 a_ = *(const float4*)(ptr), b_ = *(const float4*)((ptr) + 4); \
  dst[0] = a_.x; dst[1] = a_.y; dst[2] = a_.z; dst[3] = a_.w; dst[4] = b_.x; dst[5] = b_.y; dst[6] = b_.z; dst[7] = b_.w; }
__device__ __forceinline__ float wave_sum(float v) {
#pragma unroll
  for (int o = 32; o > 0; o >>= 1) v += __shfl_xor(v, o);
  return v;
}

struct LdPlain {
  const u16* base; long ld;
  __device__ __forceinline__ bf16x8 get(int r, int k) const { return *(const bf16x8*)(base + (long)r * ld + k); }
};

template <bool SW, class AL, class BL>
__device__ __forceinline__ void gemm_core(const AL& al, const BL& bl, int nk32, u16* smem, f32x4 (&acc)[4][4], int tid) {
  const int nk = nk32 >> 1;
  const int lane = tid & 63, wid = tid >> 6, wr = wid >> 1, wc = wid & 1, fr = lane & 15, fq = lane >> 4;
  u16* sA = smem;
  u16* sB = smem + 16384;
  const int r0 = tid >> 3, c8 = tid & 7, kc = c8 * 8;
  const int wo = r0 * 64 + ((c8 ^ ((r0 >> 1) & 7)) * 8);
  const int sw = (fr >> 1) & 7;
  const int rs0 = ((fq) ^ sw) * 8, rs1 = ((4 + fq) ^ sw) * 8;
  const int ra_off = (wr * 64 + fr) * 64;
  const int rb_off = (wc * 64 + fr) * 64;
#pragma unroll
  for (int m = 0; m < 4; m++)
#pragma unroll
    for (int n = 0; n < 4; n++) acc[m][n] = (f32x4){0.f, 0.f, 0.f, 0.f};
  bf16x8 ga[4], gb[4];
#pragma unroll
  for (int i = 0; i < 4; i++) { ga[i] = al.get(r0 + 32 * i, kc); gb[i] = bl.get(r0 + 32 * i, kc); }
#pragma unroll
  for (int i = 0; i < 4; i++) { *(bf16x8*)(sA + wo + i * 2048) = ga[i]; *(bf16x8*)(sB + wo + i * 2048) = gb[i]; }
  __syncthreads();
  for (int kt = 0; kt < nk; kt++) {
    const int cur = kt & 1;
    const bool more = (kt + 1 < nk);
    if (more) {
      const int k = (kt + 1) * 64 + kc;
#pragma unroll
      for (int i = 0; i < 4; i++) { ga[i] = al.get(r0 + 32 * i, k); gb[i] = bl.get(r0 + 32 * i, k); }
    }
    const u16* cA = sA + cur * 8192 + ra_off;
    const u16* cB = sB + cur * 8192 + rb_off;
#pragma unroll
    for (int kk = 0; kk < 2; kk++) {
      const int rs = kk ? rs1 : rs0;
      bf16x8 At[4], Bt[4];
#pragma unroll
      for (int m = 0; m < 4; m++) At[m] = *(const bf16x8*)(cA + m * 1024 + rs);
#pragma unroll
      for (int n = 0; n < 4; n++) Bt[n] = *(const bf16x8*)(cB + n * 1024 + rs);
#pragma unroll
      for (int m = 0; m < 4; m++)
#pragma unroll
        for (int n = 0; n < 4; n++)
          acc[m][n] = SW ? __builtin_amdgcn_mfma_f32_16x16x32_bf16(Bt[n], At[m], acc[m][n], 0, 0, 0)
                         : __builtin_amdgcn_mfma_f32_16x16x32_bf16(At[m], Bt[n], acc[m][n], 0, 0, 0);
    }
    if (more) {
      u16* nA = sA + (cur ^ 1) * 8192 + wo;
      u16* nB = sB + (cur ^ 1) * 8192 + wo;
#pragma unroll
      for (int i = 0; i < 4; i++) { *(bf16x8*)(nA + i * 2048) = ga[i]; *(bf16x8*)(nB + i * 2048) = gb[i]; }
    }
    __syncthreads();
  }
}

template <bool SW>
__device__ __forceinline__ void gemm_core_plain(const u16* Abase, long lda, const u16* Bbase, long ldb, int nk32, u16* smem,
                                                f32x4 (&acc)[4][4], int tid, bool zero = true) {
  const int nk = nk32 >> 1;
  const int lane = tid & 63, wid = tid >> 6, wr = wid >> 1, wc = wid & 1, fr = lane & 15, fq = lane >> 4;
  u16* sA = smem;
  u16* sB = smem + 16384;
  const int r0 = tid >> 3, c8 = tid & 7;
  const int kc = (c8 ^ ((r0 >> 1) & 7)) * 8;
  const int sw = (fr >> 1) & 7;
  const int rs0 = ((fq) ^ sw) * 8, rs1 = ((4 + fq) ^ sw) * 8;
  const int ra_off = (wr * 64 + fr) * 64;
  const int rb_off = (wc * 64 + fr) * 64;
  const u16* pa = Abase + (long)r0 * lda + kc;
  const u16* pb = Bbase + (long)r0 * ldb + kc;
  const long sa32 = 32 * lda, sb32 = 32 * ldb;
  if (zero) {
#pragma unroll
    for (int m = 0; m < 4; m++)
#pragma unroll
      for (int n = 0; n < 4; n++) acc[m][n] = (f32x4){0.f, 0.f, 0.f, 0.f};
  }
#define GP_STAGE(BUF, T)                                                                         \
  {                                                                                              \
    const u16* qa = pa + (long)(T) * 64; const u16* qb = pb + (long)(T) * 64;                    \
    char* la = (char*)(sA + (BUF) * 8192) + tid * 16; char* lb = (char*)(sB + (BUF) * 8192) + tid * 16; \
    _Pragma("unroll") for (int i = 0; i < 4; i++)                                                \
      __builtin_amdgcn_global_load_lds((const unsigned*)(qb + i * sb32), (unsigned*)(lb + i * 4096), 16, 0, 0); \
    _Pragma("unroll") for (int i = 0; i < 4; i++)                                                \
      __builtin_amdgcn_global_load_lds((const unsigned*)(qa + i * sa32), (unsigned*)(la + i * 4096), 16, 0, 0); \
  }
  GP_STAGE(0, 0)
  asm volatile("s_waitcnt vmcnt(0)" ::: "memory");
  __syncthreads();
  for (int kt = 0; kt < nk; kt++) {
    const int cur = kt & 1;
    if (kt + 1 < nk) GP_STAGE(cur ^ 1, kt + 1)
    const u16* cA = sA + cur * 8192 + ra_off;
    const u16* cB = sB + cur * 8192 + rb_off;
#pragma unroll
    for (int kk = 0; kk < 2; kk++) {
      const int rs = kk ? rs1 : rs0;
      bf16x8 At[4], Bt[4];
#pragma unroll
      for (int m = 0; m < 4; m++) At[m] = *(const bf16x8*)(cA + m * 1024 + rs);
#pragma unroll
      for (int n = 0; n < 4; n++) Bt[n] = *(const bf16x8*)(cB + n * 1024 + rs);
      __builtin_amdgcn_s_setprio(1);
#pragma unroll
      for (int m = 0; m < 4; m++)
#pragma unroll
        for (int n = 0; n < 4; n++)
          acc[m][n] = SW ? __builtin_amdgcn_mfma_f32_16x16x32_bf16(Bt[n], At[m], acc[m][n], 0, 0, 0)
                         : __builtin_amdgcn_mfma_f32_16x16x32_bf16(At[m], Bt[n], acc[m][n], 0, 0, 0);
      __builtin_amdgcn_s_setprio(0);
    }
    asm volatile("s_waitcnt vmcnt(0)" ::: "memory");
    __syncthreads();
  }
#undef GP_STAGE
}

#define GEMM_IDS \
  bid = opaque_s(bid); \
  const int tid = opaque_v(threadIdx.x), lane = tid & 63, wid = tid >> 6, wr = wid >> 1, wc = wid & 1, fr = lane & 15, fq = lane >> 4; \
  (void)tid; (void)lane; (void)wid; (void)wr; (void)wc; (void)fr; (void)fq;

__device__ __forceinline__ void tile_map(int L, int ntiles, int MT, int NT, int& tm, int& tn) {
  const int per = ntiles >> 3;
  const int t = (L & 7) * per + (L >> 3);
  const int grp = 8 * NT;
  const int g = t / grp, r = t - g * grp;
  const int rem = MT - g * 8;
  const int gsz = rem < 8 ? rem : 8;
  tm = g * 8 + r % gsz; tn = r / gsz;
}

__device__ __forceinline__ int band_map(int L, int nfull) {
  return (L < nfull) ? ((L & 7) * (nfull >> 3) + (L >> 3)) : L;
}

struct RowInfo { int is_ctx, b, t0; long srow0; };
__device__ __forceinline__ RowInfo row_info(int r, int m0) {
  RowInfo ri;
  if (m0 < MX) { int bl = m0 / SEQ; ri.is_ctx = 0; ri.t0 = m0 % SEQ; ri.b = r * NBR + bl; ri.srow0 = (long)ri.b * SEQ + ri.t0; }
  else { int mc = m0 - MX; int bl = mc / CTX; ri.is_ctx = 1; ri.t0 = mc % CTX; ri.b = r * NBR + bl; ri.srow0 = (long)ri.b * CTX + ri.t0; }
  return ri;
}

__device__ __forceinline__ void phase_mods(const P& p, int bid, int nb, float* smf) {
  float* sc = smf;
  float* red = smf + 5120;
  bid = opaque_s(bid);
  const int tid = opaque_v(threadIdx.x);
  if (bid >= 192) return;
  for (int i = tid; i < 5120; i += 256) {
    int s = i >> 10, k = i & 1023;
    float v = s < 4 ? p.c[s * 1024 + k] : p.c_ctx[k];
    sc[i] = v / (1.f + expf(-v));
  }
  __syncthreads();
  float* mods = (float*)(p.ws + OFF_MODS);
  for (int task = bid; task < 192; task += nb) {
    int layer = task / 48, n0 = (task % 48) * 64;
    int col = tid & 63, kg = tid >> 6;
    const float* w = p.ada_w + (long)layer * 1024 * 3072 + n0 + col;
    float a0 = 0, a1 = 0, a2 = 0, a3 = 0, a4 = 0;
#pragma unroll 8
    for (int k = kg * 256; k < kg * 256 + 256; k++) {
      float wv = w[(long)k * 3072];
      a0 += sc[k] * wv; a1 += sc[1024 + k] * wv; a2 += sc[2048 + k] * wv; a3 += sc[3072 + k] * wv; a4 += sc[4096 + k] * wv;
    }
    red[(kg * 5 + 0) * 64 + col] = a0; red[(kg * 5 + 1) * 64 + col] = a1; red[(kg * 5 + 2) * 64 + col] = a2;
    red[(kg * 5 + 3) * 64 + col] = a3; red[(kg * 5 + 4) * 64 + col] = a4;
    __syncthreads();
    if (tid < 64) {
      float bb = p.ada_b[layer * 3072 + n0 + tid];
#pragma unroll
      for (int s = 0; s < 5; s++) {
        float v = red[(0 * 5 + s) * 64 + tid] + red[(1 * 5 + s) * 64 + tid] + red[(2 * 5 + s) * 64 + tid] + red[(3 * 5 + s) * 64 + tid];
        mods[(layer * 5 + s) * 3072 + n0 + tid] = v + bb;
      }
    }
    __syncthreads();
  }
}

__device__ __forceinline__ int perm_col(int np) {
  int region = np >> 10, h = (np & 1023) >> 8, c256 = np & 255;
  int tau = c256 >> 7, c = c256 & 127, wcx = c >> 6, s = (c & 63) >> 4, f = c & 15;
  int pidx = tau * 64 + wcx * 32 + (s >> 1) * 16 + f;
  int d = pidx + (s & 1) * 128;
  return region * 1024 + h * 256 + d;
}

__device__ __forceinline__ void tr_tiles(const float* src, int K, int N, u16* dst, int perm, int bid, int nb, int& rot, float* tile) {
  const int tn = N / 64, nt = (K / 64) * tn;
  bid = opaque_s(bid);
  const int tid = opaque_v(threadIdx.x), c = tid & 63, rr = tid >> 6;
  for (int t = (bid + nb - (rot % nb)) % nb; t < nt; t += nb) {
    int k0 = (t / tn) * 64, n0 = (t % tn) * 64;
    int nsrc = n0 + c;
    if (perm && nsrc < 2048) nsrc = perm_col(nsrc);
    float ld[16];
#pragma unroll
    for (int i = 0; i < 16; i++) ld[i] = src[(long)(k0 + rr + i * 4) * N + nsrc];
#pragma unroll
    for (int i = 0; i < 16; i++) tile[(rr + i * 4) * 65 + c] = ld[i];
    __syncthreads();
    {
      const int nn = tid >> 2, kq = (tid & 3) * 16;
      bf16x8 o0, o1;
#pragma unroll
      for (int j = 0; j < 8; j++) { o0[j] = (short)f2bf(tile[(kq + j) * 65 + nn]); o1[j] = (short)f2bf(tile[(kq + 8 + j) * 65 + nn]); }
      u16* dp = dst + (long)(n0 + nn) * K + k0 + kq;
      *(bf16x8*)dp = o0; *(bf16x8*)(dp + 8) = o1;
    }
    __syncthreads();
  }
  rot += nt;
}

struct TrDesc { const float* src; u16* dst; int K, N, perm; };
__device__ __forceinline__ TrDesc tr_desc(const P& p, int t) {
  char* ws = p.ws;
  TrDesc d;
  d.perm = 0;
  if (t < 2) { d.src = p.ret_w_in + (long)t * 1024 * 6144; d.dst = (u16*)(ws + WB_RET_IN) + (long)t * 6144 * 1024; d.K = 1024; d.N = 6144; d.perm = 1; }
  else if (t < 4) { int j = t - 2; d.src = p.ret_w_out + (long)j * 2048 * 1024; d.dst = (u16*)(ws + WB_RET_OUT) + (long)j * 1024 * 2048; d.K = 2048; d.N = 1024; }
  else if (t == 4) { d.src = p.gm_w_in; d.dst = (u16*)(ws + WB_GM_IN); d.K = 1024; d.N = 6144; }
  else if (t == 5) { d.src = p.gm_w_out; d.dst = (u16*)(ws + WB_GM_OUT); d.K = 2048; d.N = 1024; }
  else if (t < 10) { int i = t - 6; d.src = p.rw_w_rkvg + (long)i * 1024 * 1024; d.dst = (u16*)(ws + WB_RW_G1) + (long)i * 1024 * 1024; d.K = 1024; d.N = 1024; }
  else if (t < 12) { int i = t - 10; d.src = p.rw_w1 + (long)i * 1024 * 64; d.dst = (u16*)(ws + WB_RW_G1) + (long)(4096 + 64 * i) * 1024; d.K = 1024; d.N = 64; }
  else if (t < 14) { int i = t - 12; d.src = p.rw_a1 + (long)i * 1024 * 64; d.dst = (u16*)(ws + WB_RW_G1) + (long)(4224 + 64 * i) * 1024; d.K = 1024; d.N = 64; }
  else if (t < 16) { int i = t - 14; d.src = p.rw_w2 + (long)i * 64 * 1024; d.dst = (u16*)(ws + WB_RW_G2) + (long)i * 65536; d.K = 64; d.N = 1024; }
  else if (t < 18) { int i = t - 16; d.src = p.rw_a2 + (long)i * 64 * 1024; d.dst = (u16*)(ws + WB_RW_G2) + (long)(2 + i) * 65536; d.K = 64; d.N = 1024; }
  else { d.src = p.rw_w_out; d.dst = (u16*)(ws + WB_RW_OUT); d.K = 1024; d.N = 1024; }
  return d;
}

__device__ __forceinline__ void phase_weights(const P& p, int bid, int nb, float* smf) {
  int rot = 192;
  char* ws = p.ws;
#pragma unroll 1
  for (int t = 0; t < 19; t++) {
    TrDesc d = tr_desc(p, t);
    tr_tiles(d.src, d.K, d.N, d.dst, d.perm, bid, nb, rot, smf);
  }
  {
    u16* dws = (u16*)(ws + WB_GM_WS);
    for (int i = bid * 256 + threadIdx.x; i < 8 * 128 * 128; i += nb * 256) dws[i] = f2bf(p.gm_w_s[i]);
    float2* tab = (float2*)(ws + OFF_ROPE);
    for (int i = bid * 256 + threadIdx.x; i < 128 * 64; i += nb * 256) {
      int pos = i >> 6, fi = i & 63;
      float fr = (float)pow(10000.0, -(double)fi / 64.0);
      float ang = (float)pos * fr;
      tab[i] = make_float2(cosf(ang), sinf(ang));
    }
  }
}

__device__ __forceinline__ void phase_prep(const P& p, int layer, int r, const float* xsrc, const float* csrc, u16* H, int bid, int nb) {
  bid = opaque_s(bid);
  const int tid_ = opaque_v(threadIdx.x), lane = tid_ & 63, wid = tid_ >> 6;
  const float* mods = (const float*)(p.ws + OFF_MODS);
  const float* g = p.norm_g + layer * 1024;
  for (int m = bid * 4 + wid; m < MR; m += nb * 4) {
    RowInfo ri = row_info(r, m & ~127);
    const float* src = (ri.is_ctx ? csrc : xsrc) + (ri.srow0 + (m & 127)) * 1024;
    const float* md = mods + (layer * 5 + (ri.is_ctx ? 4 : ri.b)) * 3072;
    float4 v[4];
    float ss = 0.f;
#pragma unroll
    for (int i = 0; i < 4; i++) { v[i] = *(const float4*)(src + i * 256 + lane * 4); ss += v[i].x * v[i].x + v[i].y * v[i].y + v[i].z * v[i].z + v[i].w * v[i].w; }
    ss = wave_sum(ss);
    float rs = rsqrtf(ss * (1.f / 1024.f) + 1e-6f);
#pragma unroll
    for (int i = 0; i < 4; i++) {
      int k = i * 256 + lane * 4;
      float4 gg = *(const float4*)(g + k), sh = *(const float4*)(md + k), scl = *(const float4*)(md + 1024 + k);
      ushort4 o;
      o.x = f2bf(v[i].x * rs * gg.x * (1.f + scl.x) + sh.x);
      o.y = f2bf(v[i].y * rs * gg.y * (1.f + scl.y) + sh.y);
      o.z = f2bf(v[i].z * rs * gg.z * (1.f + scl.z) + sh.z);
      o.w = f2bf(v[i].w * rs * gg.w * (1.f + scl.w) + sh.w);
      *(ushort4*)(H + (long)m * 1024 + k) = o;
    }
  }
}

__device__ __forceinline__ void phase_outproj(const P& p, int layer, int r, const u16* G, int Kdim, const u16* Wt,
                              const float* xsrc, const float* csrc, float* xdst, float* cdst, int bid, int nb, u16* smem) {
  GEMM_IDS
  const float* mods = (const float*)(p.ws + OFF_MODS);
  const int ntiles = (layer == 3 ? (MX / 128) : (MR / 128)) * 8;
  for (int tile = bid; tile < ntiles; tile += nb) {
    int tm, tn; tile_map(tile, ntiles, ntiles >> 3, 8, tm, tn);
    int m0 = tm * 128, n0 = tn * 128;
    f32x4 acc[4][4];
    gemm_core_plain<true>(G + (long)m0 * Kdim, Kdim, Wt + (long)n0 * Kdim, Kdim, Kdim / 32, smem, acc, tid);
    RowInfo ri = row_info(r, m0);
    const float* gate = mods + (layer * 5 + (ri.is_ctx ? 4 : ri.b)) * 3072 + 2048;
    const float* src = (ri.is_ctx ? csrc : xsrc) + ri.srow0 * 1024;
    float* dst = (ri.is_ctx ? cdst : xdst) + ri.srow0 * 1024;
#pragma unroll
    for (int ni = 0; ni < 4; ni++) {
      int n = n0 + wc * 64 + ni * 16 + fq * 4;
      float4 gt = *(const float4*)(gate + n);
#pragma unroll
      for (int mi = 0; mi < 4; mi++) {
        int ml = wr * 64 + mi * 16 + fr;
        long o = (long)ml * 1024 + n;
        float4 sv = *(const float4*)(src + o);
        float4 ov = make_float4(sv.x + gt.x * acc[mi][ni][0], sv.y + gt.y * acc[mi][ni][1], sv.z + gt.z * acc[mi][ni][2], sv.w + gt.w * acc[mi][ni][3]);
        *(float4*)(dst + o) = ov;
      }
    }
  }
}

__device__ __forceinline__ float log2_decay(const P& p, int jl, int dir, int h) {
  float x = p.ret_decay[(jl * 2 + dir) * 4 + h];
  float ls = -log1pf(expf(-x));
  return ls * 1.4426950408889634f;
}

__device__ __forceinline__ void phase_ret_inproj(const P& p, int r, int jl, const u16* H, const u16* Wt, u16* Q, u16* Kb, u16* KTF, u16* KTB, u16* VT, u16* Z,
                                 int bid, int nb, u16* smem) {
  GEMM_IDS
  const float2* tab = (const float2*)(p.ws + OFF_ROPE);
  const int ntiles = (MR / 128) * 48;
  for (int tile = bid; tile < ntiles; tile += nb) {
    int tm, tn; tile_map(tile, ntiles, MR / 128, 48, tm, tn);
    int m0 = tm * 128, n0 = tn * 128;
    f32x4 acc[4][4];
    gemm_core_plain<false>(H + (long)m0 * 1024, 1024, Wt + (long)n0 * 1024, 1024, 32, smem, acc, tid);
    RowInfo ri = row_info(r, m0);
    if (n0 < 2048) {
      const int region = n0 >> 10;
      const int tau = (n0 & 255) >> 7;
      const int cbase = (n0 & 1023) + wc * 64;
      u16* dstb = region ? Kb : Q;
      const float scl = region ? 0.0625f : 1.f;
      const int hh = (n0 & 1023) >> 8;
      const float lf2k = log2_decay(p, jl, 0, hh), lb2k = log2_decay(p, jl, 1, hh);
      const int LcT = ri.is_ctx ? 256 : 512;
#pragma unroll
      for (int pr = 0; pr < 2; pr++) {
        const int pidx = tau * 64 + wc * 32 + pr * 16 + fr;
        const int c1 = cbase + (2 * pr) * 16 + fr, c2 = c1 + 16;
#pragma unroll
        for (int mi = 0; mi < 4; mi++) {
          const int mlb = wr * 64 + mi * 16 + fq * 4;
          ushort4 a, b, af, bf, ab, bb;
#define ROPE_J(J, AX, BX, FX, GX, PX, QX)                                                          \
          {                                                                                        \
            float t1 = acc[mi][2 * pr][J] * scl, t2 = acc[mi][2 * pr + 1][J] * scl;                \
            float v1 = t1, v2 = t2;                                                                \
            const int t = ri.t0 + mlb + J;                                                         \
            if (!ri.is_ctx) {                                                                      \
              float2 cs = (pidx < 64) ? tab[(t >> 6) * 64 + pidx] : tab[(t & 63) * 64 + (pidx - 64)]; \
              v1 = t1 * cs.x - t2 * cs.y;                                                          \
              v2 = t1 * cs.y + t2 * cs.x;                                                          \
            }                                                                                      \
            AX = f2bf(v1); BX = f2bf(v2);                                                          \
            long row = (long)(m0 + mlb + J) * 1024;                                                \
            dstb[row + c1] = AX;                                                                   \
            dstb[row + c2] = BX;                                                                   \
            if (region) {                                                                          \
              const int jj = ri.is_ctx ? t : (t & 511);                                            \
              const float sf = fexp2((float)(LcT - 1 - jj) * lf2k), sb = fexp2((float)jj * lb2k);  \
              FX = f2bf(v1 * sf); GX = f2bf(v2 * sf); PX = f2bf(v1 * sb); QX = f2bf(v2 * sb);      \
            }                                                                                      \
          }
          ROPE_J(0, a.x, b.x, af.x, bf.x, ab.x, bb.x) ROPE_J(1, a.y, b.y, af.y, bf.y, ab.y, bb.y)
          ROPE_J(2, a.z, b.z, af.z, bf.z, ab.z, bb.z) ROPE_J(3, a.w, b.w, af.w, bf.w, ab.w, bb.w)
#undef ROPE_J
          if (region) {
            *(ushort4*)(KTF + (long)c1 * MR + m0 + mlb) = af;
            *(ushort4*)(KTF + (long)c2 * MR + m0 + mlb) = bf;
            *(ushort4*)(KTB + (long)c1 * MR + m0 + mlb) = ab;
            *(ushort4*)(KTB + (long)c2 * MR + m0 + mlb) = bb;
          }
        }
      }
    } else if (n0 < 4096) {
#pragma unroll
      for (int mi = 0; mi < 4; mi++)
#pragma unroll
        for (int ni = 0; ni < 4; ni++) {
          int col = n0 - 2048 + wc * 64 + ni * 16 + fr;
          int mrow = m0 + wr * 64 + mi * 16 + fq * 4;
          ushort4 a = pack4(acc[mi][ni][0], acc[mi][ni][1], acc[mi][ni][2], acc[mi][ni][3]);
          *(ushort4*)(VT + (long)col * MR + mrow) = a;
        }
    } else {
#pragma unroll
      for (int mi = 0; mi < 4; mi++)
#pragma unroll
        for (int ni = 0; ni < 4; ni++)
#pragma unroll
          for (int j = 0; j < 4; j++) {
            int ml = wr * 64 + mi * 16 + fq * 4 + j;
            int col = n0 - 4096 + wc * 64 + ni * 16 + fr;
            Z[(long)(m0 + ml) * 2048 + col] = f2bf(acc[mi][ni][j]);
          }
    }
  }
}


struct LdKtDecay {
  const u16* base; float l2; int dir; int Lc; float rstep;
  __device__ __forceinline__ bf16x8 get(int r, int k) const {
    bf16x8 v = *(const bf16x8*)(base + (long)r * MR + k);
    bf16x8 o;
    float f = exp2f((dir ? (float)k : (float)(Lc - 1 - k)) * l2);
#pragma unroll
    for (int i = 0; i < 8; i++) {
      o[i] = (short)f2bf(bf2f((u16)v[i]) * f);
      f *= rstep;
    }
    return o;
  }
};

__device__ __forceinline__ void phase_ret_state(const P& p, int jl, const u16* KTF, const u16* KTB, const u16* VT, u16* ST, int bid, int nb, u16* smem) {
  GEMM_IDS
  const int ntiles = NBR * 4 * 2 * 128;
  for (int tile = bid; tile < ntiles; tile += nb) {
    const int tl = band_map(tile, ntiles);
    int grp = tl >> 7, tt = tl & 127;
    int dir = grp & 1, h = (grp >> 1) & 3, bl = grp >> 3;
    int slot = tt >> 3, tm = (tt & 7) >> 1, tn = tt & 1;
    int cx;
    if (dir == 0) cx = (slot == 0) ? 16 : slot - 1; else cx = (slot == 15) ? 16 : slot + 1;
    int Lc = (cx == 16) ? 256 : 512;
    int tok0 = (cx == 16) ? (MX + bl * CTX) : (bl * SEQ + cx * 512);
    f32x4 acc[4][4];
    gemm_core_plain<true>(VT + (long)(h * 512 + tm * 128) * MR + tok0, MR,
                          (dir ? KTB : KTF) + (long)(h * 256 + tn * 128) * MR + tok0, MR, Lc / 32, smem, acc, tid);
    u16* dst = ST + ((long)(((bl * 4 + h) * 2 + dir) * 16 + slot)) * 131072;
#pragma unroll
    for (int mi = 0; mi < 4; mi++)
#pragma unroll
      for (int ni = 0; ni < 4; ni++) {
        int dv = tm * 128 + wr * 64 + mi * 16 + fr;
        int dk = tn * 128 + wc * 64 + ni * 16 + fq * 4;
        ushort4 a = pack4(acc[mi][ni][0], acc[mi][ni][1], acc[mi][ni][2], acc[mi][ni][3]);
        *(ushort4*)(dst + dv * 256 + dk) = a;
      }
  }
}

__device__ __forceinline__ void phase_ret_scan(const P& p, int jl, u16* ST, int bid, int nb) {
  const int ntask = NBR * 4 * 2 * 16384;
  for (int task = opaque_s(bid) * 256 + opaque_v(threadIdx.x); task < ntask; task += nb * 256) {
    int grp = task >> 14, e8 = (task & 16383) * 8;
    int dir = grp & 1, h = (grp >> 1) & 3;
    float cd = exp2f(512.f * log2_decay(p, jl, dir, h));
    u16* base = ST + (long)grp * 16 * 131072 + e8;
    const long first = dir ? 15L * 131072 : 0L, step = dir ? -131072L : 131072L;
    bf16x8 v[16];
#pragma unroll
    for (int i = 0; i < 16; i++) v[i] = *(const bf16x8*)(base + first + i * step);
    float cur[8];
#pragma unroll
    for (int e = 0; e < 8; e++) cur[e] = bf2f((u16)v[0][e]);
#pragma unroll
    for (int i = 1; i < 16; i++) {
      bf16x8 o;
#pragma unroll
      for (int e = 0; e < 8; e++) { cur[e] = cur[e] * cd + bf2f((u16)v[i][e]); o[e] = (short)f2bf(cur[e]); }
      *(bf16x8*)(base + first + i * step) = o;
    }
  }
}

constexpr long P_PER_BH = 16L * 512 * 512 + 256 * 256;

__device__ __forceinline__ void phase_ret_scores(const P& p, int jl, const u16* Q, const u16* Kb, u16* PB, int bid, int nb, u16* smem) {
  GEMM_IDS
  const int ntiles = NBR * 4 * 260;
  for (int tile = bid; tile < ntiles; tile += nb) {
    int tb, tt;
    const int tl = band_map(tile, NBR * 4 * 256);
    if (tl < NBR * 4 * 256) { tb = tl >> 8; tt = tl & 255; } else { int idx = tl - NBR * 4 * 256; tb = idx >> 2; tt = 256 + (idx & 3); }
    int bl = tb >> 2, h = tb & 3;
    int cx, ti, tj, Lc;
    if (tt < 256) { cx = tt >> 4; ti = (tt & 15) >> 2; tj = tt & 3; Lc = 512; }
    else { cx = 16; ti = (tt - 256) >> 1; tj = (tt - 256) & 1; Lc = 256; }
    int tok0 = (cx == 16) ? (MX + bl * CTX) : (bl * SEQ + cx * 512);
    f32x4 acc[4][4];
    gemm_core_plain<true>(Q + (long)(tok0 + ti * 128) * 1024 + h * 256, 1024, Kb + (long)(tok0 + tj * 128) * 1024 + h * 256, 1024, 8, smem, acc, tid);
    float lf2 = log2_decay(p, jl, 0, h), lb2 = log2_decay(p, jl, 1, h);
    u16* dst = PB + (long)tb * P_PER_BH + (long)cx * 262144;
#pragma unroll
    for (int mi = 0; mi < 4; mi++)
#pragma unroll
      for (int ni = 0; ni < 4; ni++) {
        int i = ti * 128 + wr * 64 + mi * 16 + fr;
        int jx0 = tj * 128 + wc * 64 + ni * 16 + fq * 4;
        u16 o4[4];
#pragma unroll
        for (int j = 0; j < 4; j++) {
          int d = i - (jx0 + j);
          float mk = (d >= 0 ? fexp2((float)d * lf2) : 0.f) + (d <= 0 ? fexp2((float)(-d) * lb2) : 0.f);
          o4[j] = f2bf(acc[mi][ni][j] * mk);
        }
        *(ushort4*)(dst + (long)i * Lc + jx0) = make_ushort4(o4[0], o4[1], o4[2], o4[3]);
      }
  }
}

struct LdOA {
  const u16* Pp; int Lc; const u16* q; int i0; float lf2, lb2;
  __device__ __forceinline__ bf16x8 get(int r, int k) const {
    if (k < Lc) return *(const bf16x8*)(Pp + (long)r * Lc + k);
    int kk = k - Lc; int seg = kk >> 8, dk = kk & 255; int i = i0 + r;
    float sc = seg == 0 ? exp2f((float)(i + 1) * lf2) : exp2f((float)(Lc - i) * lb2);
    bf16x8 v = *(const bf16x8*)(q + (long)r * 1024 + dk);
    bf16x8 o;
#pragma unroll
    for (int e = 0; e < 8; e++) o[e] = (short)f2bf(bf2f((u16)v[e]) * sc);
    return o;
  }
};
struct LdOB {
  const u16* vt; const u16* sf; const u16* sb; int Lc;
  __device__ __forceinline__ bf16x8 get(int r, int k) const {
    if (k < Lc) return *(const bf16x8*)(vt + (long)r * MR + k);
    int kk = k - Lc;
    if (kk < 256) return *(const bf16x8*)(sf + r * 256 + kk);
    return *(const bf16x8*)(sb + r * 256 + (kk - 256));
  }
};

__device__ __forceinline__ void phase_ret_o(const P& p, int jl, const u16* Q, const u16* VT, const u16* PB, const u16* ST, u16* O, int bid, int nb, u16* smem) {
  GEMM_IDS
  const int ntiles = NBR * 4 * 264;
  for (int tile = bid; tile < ntiles; tile += nb) {
    int tb, tt;
    const int tl = band_map(tile, NBR * 4 * 256);
    if (tl < NBR * 4 * 256) { tb = tl >> 8; tt = tl & 255; } else { int idx = tl - NBR * 4 * 256; tb = idx >> 3; tt = 256 + (idx & 7); }
    int bl = tb >> 2, h = tb & 3;
    int cx, ti, tn, Lc;
    if (tt < 256) { cx = tt >> 4; ti = (tt & 15) >> 2; tn = tt & 3; Lc = 512; }
    else { cx = 16; ti = (tt - 256) >> 2; tn = (tt - 256) & 3; Lc = 256; }
    int tok0 = (cx == 16) ? (MX + bl * CTX) : (bl * SEQ + cx * 512);
    f32x4 acc[4][4];
    const u16* Pp = PB + (long)tb * P_PER_BH + (long)cx * 262144 + (long)(ti * 128) * Lc;
    const u16* Vp = VT + (long)(h * 512 + tn * 128) * MR + tok0;
    {
      const float lf2 = log2_decay(p, jl, 0, h), lb2 = log2_decay(p, jl, 1, h);
      const u16* qa = Q + (long)(tok0 + ti * 128) * 1024 + h * 256;
      const int slx = (cx == 16) ? 0 : cx;
      const u16* sfp = ST + ((long)(((bl * 4 + h) * 2 + 0) * 16 + slx)) * 131072 + (long)(tn * 128) * 256;
      const u16* sbp = ST + ((long)(((bl * 4 + h) * 2 + 1) * 16 + slx)) * 131072 + (long)(tn * 128) * 256;
      const int seg0 = (cx == 16) ? 2 : 0;
#pragma unroll 1
      for (int seg = seg0; seg < 3; seg++) {
        const u16* Ap = (seg == 2) ? Pp : qa;
        const u16* Bp = (seg == 2) ? Vp : (seg == 0 ? sbp : sfp);
        const long la = (seg == 2) ? (long)Lc : 1024L, lb = (seg == 2) ? (long)MR : 256L;
        const int nk32 = (seg == 2) ? Lc / 32 : 8;
        gemm_core_plain<true>(Ap, la, Bp, lb, nk32, smem, acc, tid, seg == seg0);
        if (seg < 2) {
#pragma unroll
          for (int mi = 0; mi < 4; mi++) {
            const int i = ti * 128 + wr * 64 + mi * 16 + fr;
            const float e = (seg == 0) ? ((float)(Lc - i) * lb2 - (float)(i + 1) * lf2) : ((float)(i + 1) * lf2);
            const float sc = exp2f(e);
#pragma unroll
            for (int ni = 0; ni < 4; ni++) { acc[mi][ni][0] *= sc; acc[mi][ni][1] *= sc; acc[mi][ni][2] *= sc; acc[mi][ni][3] *= sc; }
          }
        }
      }
    }
#pragma unroll
    for (int mi = 0; mi < 4; mi++)
#pragma unroll
      for (int ni = 0; ni < 4; ni++) {
        int ml = ti * 128 + wr * 64 + mi * 16 + fr;
        int col = h * 512 + tn * 128 + wc * 64 + ni * 16 + fq * 4;
        ushort4 a = pack4(acc[mi][ni][0], acc[mi][ni][1], acc[mi][ni][2], acc[mi][ni][3]);
        *(ushort4*)(O + (long)(tok0 + ml) * 2048 + col) = a;
      }
  }
}

__device__ __forceinline__ float row16_sum(float v);
__device__ __forceinline__ void phase_ret_gate(u16* O, const u16* Z, int bid, int nb) {
  bid = opaque_s(bid);
  const int tid_ = opaque_v(threadIdx.x), lane = tid_ & 63, wid = tid_ >> 6;
  for (int m = bid * 4 + wid; m < MR; m += nb * 4) {
    long off = (long)m * 2048 + lane * 32;
    bf16x8 ov[4], zv[4];
#pragma unroll
    for (int i = 0; i < 4; i++) { ov[i] = *(const bf16x8*)(O + off + i * 8); zv[i] = *(const bf16x8*)(Z + off + i * 8); }
    float ss = 0.f;
#pragma unroll
    for (int i = 0; i < 4; i++)
#pragma unroll
      for (int e = 0; e < 8; e++) { float f = bf2f((u16)ov[i][e]); ss += f * f; }
    ss = row16_sum(ss);
    float rs = rsqrtf(ss * (1.f / 512.f) + 1e-6f);
#pragma unroll
    for (int i = 0; i < 4; i++) {
      bf16x8 o;
#pragma unroll
      for (int e = 0; e < 8; e++) o[e] = (short)f2bf(bf2f((u16)ov[i][e]) * rs * siluf(bf2f((u16)zv[i][e])));
      *(bf16x8*)(O + off + i * 8) = o;
    }
  }
}

__device__ __forceinline__ void phase_gm_inproj(const u16* H, const u16* Wt, u16* U3, int bid, int nb, u16* smem) {
  GEMM_IDS
  const int ntiles = (MR / 128) * 48;
  for (int tile = bid; tile < ntiles; tile += nb) {
    int tm, tn; tile_map(tile, ntiles, MR / 128, 48, tm, tn);
    int m0 = tm * 128, n0 = tn * 128;
    f32x4 acc[4][4];
    gemm_core_plain<true>(H + (long)m0 * 1024, 1024, Wt + (long)n0 * 1024, 1024, 32, smem, acc, tid);
    u16* dst = U3 + (long)(n0 >> 11) * MR * 2048;
#pragma unroll
    for (int mi = 0; mi < 4; mi++)
#pragma unroll
      for (int ni = 0; ni < 4; ni++) {
        int ml = wr * 64 + mi * 16 + fr;
        int col = (n0 & 2047) + wc * 64 + ni * 16 + fq * 4;
        ushort4 a = pack4(acc[mi][ni][0], acc[mi][ni][1], acc[mi][ni][2], acc[mi][ni][3]);
        *(ushort4*)(dst + (long)(m0 + ml) * 2048 + col) = a;
      }
  }
}

__device__ __forceinline__ void phase_gm_vstats(const u16* VR, float* stats, int bid, int nb) {
  bid = opaque_s(bid);
  const int tid_ = opaque_v(threadIdx.x), lane = tid_ & 63, wid = tid_ >> 6;
  for (int m = bid * 4 + wid; m < MR; m += nb * 4) {
    const u16* src = VR + (long)m * 2048;
    float s = 0.f, s2 = 0.f;
#pragma unroll
    for (int i = 0; i < 4; i++) {
      bf16x8 v = *(const bf16x8*)(src + i * 512 + lane * 8);
#pragma unroll
      for (int e = 0; e < 8; e++) { float f = bf2f((u16)v[e]); s += f; s2 += f * f; }
    }
    s = wave_sum(s); s2 = wave_sum(s2);
    float mean = s * (1.f / 2048.f);
    float var = s2 * (1.f / 2048.f) - mean * mean;
    if (lane == 0) { stats[m * 2] = mean; stats[m * 2 + 1] = rsqrtf(fmaxf(var, 0.f) + 1e-6f); }
  }
}

__device__ __forceinline__ void phase_gm_vtrans(const P& p, const u16* VR, const float* stats, u16* VT, int bid, int nb, float* smf) {
  u16* T = (u16*)smf;
  bid = opaque_s(bid);
  const int tid = opaque_v(threadIdx.x);
  for (int task = bid; task < (MR / 128) * 32; task += nb) {
    const int chunk = task >> 5, cb = task & 31;
    const int m0 = chunk * 128;
#pragma unroll
    for (int i = 0; i < 4; i++) {
      int q = tid + i * 256;
      int jj = q >> 3, c8 = (q & 7) * 8;
      bf16x8 v = *(const bf16x8*)(VR + (long)(m0 + jj) * 2048 + cb * 64 + c8);
      float2 st = *(const float2*)(stats + (m0 + jj) * 2);
      float g8[8];
      LD8F(g8, p.gm_vnorm_g + cb * 64 + c8)
#pragma unroll
      for (int e = 0; e < 8; e++) T[(c8 + e) * 136 + jj] = f2bf((bf2f((u16)v[e]) - st.x) * st.y * g8[e]);
    }
    __syncthreads();
#pragma unroll
    for (int i = 0; i < 4; i++) {
      int q = tid + i * 256;
      int ch = q >> 4, j8 = (q & 15) * 8;
      bf16x8 v = *(const bf16x8*)(T + ch * 136 + j8);
      *(bf16x8*)(VT + ((long)chunk * 2048 + cb * 64 + ch) * 128 + j8) = v;
    }
    __syncthreads();
  }
}

__device__ __forceinline__ void phase_gm_spatial(const P& p, const u16* WS, const u16* VT, u16* U, const u16* Z, int bid, int nb, u16* smem) {
  GEMM_IDS
  const int ntiles = (MR / 128) * 16;
  for (int tile = bid; tile < ntiles; tile += nb) {
    const int tl = band_map(tile, ntiles);
    int chunk = tl >> 4, g = (tl >> 1) & 7, tn = tl & 1;
    f32x4 acc[4][4];
    gemm_core_plain<true>(WS + g * 16384, 128, VT + ((long)chunk * 2048 + g * 256 + tn * 128) * 128, 128, 4, smem, acc, tid);
#pragma unroll
    for (int mi = 0; mi < 4; mi++) {
      int ml = wr * 64 + mi * 16 + fr;
      float bs = p.gm_b_s[g * 128 + ml];
#pragma unroll
      for (int ni = 0; ni < 4; ni++) {
        int col = g * 256 + tn * 128 + wc * 64 + ni * 16 + fq * 4;
        long o = (long)(chunk * 128 + ml) * 2048 + col;
        ushort4 u4 = *(const ushort4*)(U + o), z4 = *(const ushort4*)(Z + o);
        ushort4 r4;
        r4.x = f2bf(bf2f(u4.x) * (acc[mi][ni][0] + bs) * siluf(bf2f(z4.x)));
        r4.y = f2bf(bf2f(u4.y) * (acc[mi][ni][1] + bs) * siluf(bf2f(z4.y)));
        r4.z = f2bf(bf2f(u4.z) * (acc[mi][ni][2] + bs) * siluf(bf2f(z4.z)));
        r4.w = f2bf(bf2f(u4.w) * (acc[mi][ni][3] + bs) * siluf(bf2f(z4.w)));
        *(ushort4*)(U + o) = r4;
      }
    }
  }
}

struct LdMix {
  const u16* H; int m0; int is_ctx; int t0; const float* mu;
  __device__ __forceinline__ bf16x8 get(int r, int k) const {
    int m = m0 + r, t = t0 + r;
    int d; bool valid;
    if (is_ctx) { if (k < 512) { d = -1; valid = t > 0; } else { d = 1; valid = t < CTX - 1; } }
    else {
      int q = k >> 8, cl = t & 63, rw = t >> 6;
      if (q == 0) { d = -1; valid = cl > 0; } else if (q == 1) { d = 1; valid = cl < 63; }
      else if (q == 2) { d = -64; valid = rw > 0; } else { d = 64; valid = rw < 127; }
    }
    bf16x8 hv = *(const bf16x8*)(H + (long)m * 1024 + k);
    bf16x8 sv = (bf16x8){0, 0, 0, 0, 0, 0, 0, 0};
    if (valid) sv = *(const bf16x8*)(H + (long)(m + d) * 1024 + k);
    float4 mu0 = *(const float4*)(mu + k), mu1 = *(const float4*)(mu + k + 4);
    float mm[8] = {mu0.x, mu0.y, mu0.z, mu0.w, mu1.x, mu1.y, mu1.z, mu1.w};
    bf16x8 o;
#pragma unroll
    for (int e = 0; e < 8; e++) { float hf = bf2f((u16)hv[e]), sf = bf2f((u16)sv[e]); o[e] = (short)f2bf(hf + (sf - hf) * mm[e]); }
    return o;
  }
};

__device__ __forceinline__ void phase_rw_mix(const P& p, int r, const u16* H, u16* XM, int bid, int nb) {
  bid = opaque_s(bid);
  const int tid_ = opaque_v(threadIdx.x), lane = tid_ & 63, wid = tid_ >> 6;
  const long T = (long)MR * 1024;
  for (int m = bid * 4 + wid; m < MR; m += nb * 4) {
    RowInfo ri = row_info(r, m & ~127);
    const int t = ri.t0 + (m & 127);
    const int k = lane * 16;
    int d; bool valid;
    if (ri.is_ctx) { if (k < 512) { d = -1; valid = t > 0; } else { d = 1; valid = t < CTX - 1; } }
    else {
      int q = k >> 8, cl = t & 63, rw = t >> 6;
      if (q == 0) { d = -1; valid = cl > 0; } else if (q == 1) { d = 1; valid = cl < 63; }
      else if (q == 2) { d = -64; valid = rw > 0; } else { d = 64; valid = rw < 127; }
    }
    float hf[16], xf[16];
#pragma unroll
    for (int hh = 0; hh < 2; hh++) {
      bf16x8 hv = *(const bf16x8*)(H + (long)m * 1024 + k + hh * 8);
      bf16x8 sv = (bf16x8){0, 0, 0, 0, 0, 0, 0, 0};
      if (valid) sv = *(const bf16x8*)(H + (long)(m + d) * 1024 + k + hh * 8);
#pragma unroll
      for (int e = 0; e < 8; e++) { hf[hh * 8 + e] = bf2f((u16)hv[e]); xf[hh * 8 + e] = bf2f((u16)sv[e]) - hf[hh * 8 + e]; }
    }
#pragma unroll
    for (int pm = 0; pm < 6; pm++) {
      const float* mu = p.rw_mu + pm * 1024 + k;
#pragma unroll
      for (int hh = 0; hh < 2; hh++) {
        float4 m0 = *(const float4*)(mu + hh * 8), m1 = *(const float4*)(mu + hh * 8 + 4);
        float mm[8] = {m0.x, m0.y, m0.z, m0.w, m1.x, m1.y, m1.z, m1.w};
        bf16x8 o;
#pragma unroll
        for (int e = 0; e < 8; e++) o[e] = (short)f2bf(hf[hh * 8 + e] + xf[hh * 8 + e] * mm[e]);
        *(bf16x8*)(XM + pm * T + (long)m * 1024 + k + hh * 8) = o;
      }
    }
  }
}

__device__ __forceinline__ void phase_rw_gemm1(const P& p, int r, const u16* XM, const u16* Wt, u16* R4, u16* LW, int bid, int nb, u16* smem) {
  GEMM_IDS
  const int ntiles = (MR / 128) * 34;
  for (int tile = bid; tile < ntiles; tile += nb) {
    int tm, tn; tile_map(tile, ntiles, MR / 128, 34, tm, tn);
    int m0 = tm * 128, n0 = tn * 128;
    int mixp;
    if (tn < 8) mixp = 0; else if (tn < 16) mixp = 2; else if (tn < 24) mixp = 3; else if (tn < 32) mixp = 5; else if (tn == 32) mixp = 1; else mixp = 4;
    f32x4 acc[4][4];
    gemm_core_plain<true>(XM + (long)mixp * MR * 1024 + (long)m0 * 1024, 1024, Wt + (long)n0 * 1024, 1024, 32, smem, acc, tid);
    if (tn < 32) {
      u16* dst = R4 + (long)(tn >> 3) * MR * 1024;
#pragma unroll
      for (int mi = 0; mi < 4; mi++)
#pragma unroll
        for (int ni = 0; ni < 4; ni++) {
          int ml = wr * 64 + mi * 16 + fr;
          int col = (tn & 7) * 128 + wc * 64 + ni * 16 + fq * 4;
          ushort4 a = pack4(acc[mi][ni][0], acc[mi][ni][1], acc[mi][ni][2], acc[mi][ni][3]);
          *(ushort4*)(dst + (long)(m0 + ml) * 1024 + col) = a;
        }
    } else {
#pragma unroll
      for (int mi = 0; mi < 4; mi++)
#pragma unroll
        for (int ni = 0; ni < 4; ni++) {
          int ml = wr * 64 + mi * 16 + fr;
          int col = (tn - 32) * 128 + wc * 64 + ni * 16 + fq * 4;
          float v0 = acc[mi][ni][0], v1 = acc[mi][ni][1], v2 = acc[mi][ni][2], v3 = acc[mi][ni][3];
          if (tn == 32) { v0 = tanhf(v0); v1 = tanhf(v1); v2 = tanhf(v2); v3 = tanhf(v3); }
          *(ushort4*)(LW + (long)(m0 + ml) * 256 + col) = pack4(v0, v1, v2, v3);
        }
    }
  }
}

__device__ __forceinline__ void phase_rw_gemm2(const P& p, const u16* LW, const u16* W2, u16* OM2, u16* A2, const u16* Kb, float* kinv, int bid, int nb, u16* smem) {
  GEMM_IDS
  const int per = (MR / 128) * 8;
  const int ntiles = 4 * per;
  for (int tile = bid; tile < ntiles; tile += nb) {
    const int tl = band_map(tile, ntiles);
    int q = tl / per, rem = tl % per;
    int tm = rem >> 3, tn = rem & 7;
    int m0 = tm * 128, n0 = tn * 128;
    f32x4 acc[4][4];
    gemm_core_plain<true>(LW + (long)m0 * 256 + q * 64, 256, W2 + (long)q * 65536 + (long)n0 * 64, 64, 2, smem, acc, tid);
    int d = q & 1;
    const float* bias = (q < 2 ? p.rw_w0 : p.rw_a0) + d * 1024;
    u16* dst = (q < 2 ? OM2 : A2) + (long)d * MR * 1024;
#pragma unroll
    for (int ni = 0; ni < 4; ni++) {
      int n = n0 + wc * 64 + ni * 16 + fq * 4;
      float4 bb = *(const float4*)(bias + n);
#pragma unroll
      for (int mi = 0; mi < 4; mi++) {
        int ml = wr * 64 + mi * 16 + fr;
        float u0 = bb.x + acc[mi][ni][0], u1 = bb.y + acc[mi][ni][1], u2 = bb.z + acc[mi][ni][2], u3 = bb.w + acc[mi][ni][3];
        float o0, o1, o2, o3;
        if (q < 2) {
          o0 = 1.f - __expf(-0.6065306597126334f * sigm(u0)); o1 = 1.f - __expf(-0.6065306597126334f * sigm(u1));
          o2 = 1.f - __expf(-0.6065306597126334f * sigm(u2)); o3 = 1.f - __expf(-0.6065306597126334f * sigm(u3));
        } else { o0 = sigm(u0); o1 = sigm(u1); o2 = sigm(u2); o3 = sigm(u3); }
        *(ushort4*)(dst + (long)(m0 + ml) * 1024 + n) = pack4(o0, o1, o2, o3);
      }
    }
  }
  for (int m = bid * 4 + wid; m < MR; m += nb * 4) {
    const u16* src = Kb + (long)m * 1024 + lane * 16;
    bf16x8 v0 = *(const bf16x8*)src, v1 = *(const bf16x8*)(src + 8);
    float s = 0.f;
    float kk0[8], kk1[8];
    LD8F(kk0, p.rw_k_k + lane * 16) LD8F(kk1, p.rw_k_k + lane * 16 + 8)
#pragma unroll
    for (int e = 0; e < 8; e++) {
      float a = bf2f((u16)v0[e]) * kk0[e], b = bf2f((u16)v1[e]) * kk1[e];
      s += a * a + b * b;
    }
    s += __shfl_xor(s, 1); s += __shfl_xor(s, 2);
    if ((lane & 3) == 0) kinv[m * 16 + (lane >> 2)] = 1.f / fmaxf(sqrtf(s), 1e-12f);
  }
}

__device__ __forceinline__ float row16_sum(float v) {
  int x;
  x = __builtin_amdgcn_update_dpp(0, __float_as_int(v), 0xB1, 0xF, 0xF, false); v += __int_as_float(x);
  x = __builtin_amdgcn_update_dpp(0, __float_as_int(v), 0x4E, 0xF, 0xF, false); v += __int_as_float(x);
  x = __builtin_amdgcn_update_dpp(0, __float_as_int(v), 0x141, 0xF, 0xF, false); v += __int_as_float(x);
  x = __builtin_amdgcn_update_dpp(0, __float_as_int(v), 0x140, 0xF, 0xF, false); v += __int_as_float(x);
  return v;
}

constexpr int SCAN_VS = 336;
constexpr int SCAN_STEPS = CTX + SEQ;
__device__ __forceinline__ int scan_row(int step, int dir, int bl) {
  if (step < CTX) { int t = dir ? (CTX - 1 - step) : step; return MX + bl * CTX + t; }
  int t = step - CTX; t = dir ? (SEQ - 1 - t) : t; return bl * SEQ + t;
}

__device__ __forceinline__ void phase_rw_scan(const P& p, const u16* R4, const u16* OM2, const u16* A2, const float* kinv, u16* Y2, int bid, int nb, float* smf) {
  float* buf = smf;
  bid = opaque_s(bid);
  const int tid = opaque_v(threadIdx.x), lane = tid & 63, wid = tid >> 6, rl = lane >> 4, kl = lane & 15;
  const int st_t = tid >> 4, st_k4 = (tid & 15) * 4;
  const u16* Rb = R4; const u16* Kb = R4 + (long)MR * 1024; const u16* Vb = R4 + 2L * MR * 1024;
  for (int task = bid; task < NBR * 16 * 2 * 4; task += nb) {
    const int tsk = (task < 256) ? ((task & 7) * 32 + (task >> 3)) : task;
    const int rb = tsk & 3, chain = tsk >> 2, dir = chain & 1, h = (chain >> 1) & 15, bl = chain >> 5;
    const u16* OM = OM2 + (long)dir * MR * 1024; const u16* AA = A2 + (long)dir * MR * 1024;
    u16* Y = Y2 + (long)dir * MR * 1024;
    const float4 kkc = *(const float4*)(p.rw_k_k + h * 64 + st_k4), kac = *(const float4*)(p.rw_k_a + h * 64 + st_k4);
    f32x2 s01 = {0.f, 0.f}, s23 = {0.f, 0.f};
    ushort4 gk, gr, ga, go; float gki; u16 gv;
    auto gload = [&](int blk) {
      int m = scan_row(blk * 16 + st_t, dir, bl);
      long off = (long)m * 1024 + h * 64 + st_k4;
      gk = *(const ushort4*)(Kb + off); gr = *(const ushort4*)(Rb + off); ga = *(const ushort4*)(AA + off); go = *(const ushort4*)(OM + off);
      gki = kinv[m * 16 + h];
      gv = Vb[(long)m * 1024 + h * 64 + rb * 16 + (tid & 15)];
    };
    auto gstore = [&](int b) {
      float* bp = buf + b * (16 * SCAN_VS) + st_t * SCAN_VS;
      float k0 = bf2f(gk.x), k1 = bf2f(gk.y), k2 = bf2f(gk.z), k3 = bf2f(gk.w);
      float a0 = bf2f(ga.x), a1 = bf2f(ga.y), a2 = bf2f(ga.z), a3 = bf2f(ga.w);
      float q0 = k0 * kkc.x * gki, q1 = k1 * kkc.y * gki, q2 = k2 * kkc.z * gki, q3 = k3 * kkc.w * gki;
      *(float4*)(bp + 0 + st_k4) = make_float4(-q0, -q1, -q2, -q3);
      *(float4*)(bp + 64 + st_k4) = make_float4(1.f - bf2f(go.x), 1.f - bf2f(go.y), 1.f - bf2f(go.z), 1.f - bf2f(go.w));
      *(float4*)(bp + 128 + st_k4) = make_float4(q0 * a0, q1 * a1, q2 * a2, q3 * a3);
      *(float4*)(bp + 192 + st_k4) = make_float4(k0 * (1.f + (a0 - 1.f) * kac.x), k1 * (1.f + (a1 - 1.f) * kac.y),
                                                 k2 * (1.f + (a2 - 1.f) * kac.z), k3 * (1.f + (a3 - 1.f) * kac.w));
      *(float4*)(bp + 256 + st_k4) = make_float4(bf2f(gr.x), bf2f(gr.y), bf2f(gr.z), bf2f(gr.w));
      bp[320 + (tid & 15)] = bf2f(gv);
    };
    gload(0); gstore(0);
    __syncthreads();
    const int nblk = SCAN_STEPS / 16;
    const int yrow_off = h * 64 + rb * 16 + wid * 4 + rl;
    for (int blk = 0; blk < nblk; blk++) {
      const int cur = blk & 1;
      if (blk + 1 < nblk) gload(blk + 1);
      const float* bb = buf + cur * (16 * SCAN_VS) + kl * 4;
      const float* vb = buf + cur * (16 * SCAN_VS) + 320 + wid * 4 + rl;
      float4 nk = *(const float4*)(bb), w = *(const float4*)(bb + 64), b4 = *(const float4*)(bb + 128);
      float4 kt = *(const float4*)(bb + 192), rr = *(const float4*)(bb + 256);
      float vv = vb[0];
      float yp[16];
#pragma unroll
      for (int tt = 0; tt < 16; tt++) {
        float4 nk_n, w_n, b4_n, kt_n, rr_n; float vv_n;
        if (tt + 1 < 16) {
          const float* bp = bb + (tt + 1) * SCAN_VS;
          nk_n = *(const float4*)(bp); w_n = *(const float4*)(bp + 64); b4_n = *(const float4*)(bp + 128);
          kt_n = *(const float4*)(bp + 192); rr_n = *(const float4*)(bp + 256);
          vv_n = vb[(tt + 1) * SCAN_VS];
        }
        f32x2 p2 = s01 * (f32x2){nk.x, nk.y} + s23 * (f32x2){nk.z, nk.w};
        float sa = row16_sum(p2.x + p2.y);
        const f32x2 sa2 = {sa, sa}, vv2 = {vv, vv};
        s01 = s01 * (f32x2){w.x, w.y} + sa2 * (f32x2){b4.x, b4.y} + vv2 * (f32x2){kt.x, kt.y};
        s23 = s23 * (f32x2){w.z, w.w} + sa2 * (f32x2){b4.z, b4.w} + vv2 * (f32x2){kt.z, kt.w};
        f32x2 y2 = s01 * (f32x2){rr.x, rr.y} + s23 * (f32x2){rr.z, rr.w};
        yp[tt] = y2.x + y2.y;
        if (tt + 1 < 16) { nk = nk_n; w = w_n; b4 = b4_n; kt = kt_n; rr = rr_n; vv = vv_n; }
      }
      {
        const bool gA = (kl & 8) != 0, gB = (kl & 4) != 0, gC = (kl & 2) != 0, gD = (kl & 1) != 0;
        float a8[8], a4[4], a2[2];
#pragma unroll
        for (int j = 0; j < 8; j++) {
          float keep = gA ? yp[j + 8] : yp[j], send = gA ? yp[j] : yp[j + 8];
          a8[j] = keep + __int_as_float(__builtin_amdgcn_update_dpp(0, __float_as_int(send), 0x140, 0xF, 0xF, false));
        }
#pragma unroll
        for (int j = 0; j < 4; j++) {
          float keep = gB ? a8[j + 4] : a8[j], send = gB ? a8[j] : a8[j + 4];
          a4[j] = keep + __int_as_float(__builtin_amdgcn_update_dpp(0, __float_as_int(send), 0x141, 0xF, 0xF, false));
        }
#pragma unroll
        for (int j = 0; j < 2; j++) {
          float keep = gC ? a4[j + 2] : a4[j], send = gC ? a4[j] : a4[j + 2];
          a2[j] = keep + __int_as_float(__builtin_amdgcn_update_dpp(0, __float_as_int(send), 0x4E, 0xF, 0xF, false));
        }
        float keep = gD ? a2[1] : a2[0], send = gD ? a2[0] : a2[1];
        float ysel = keep + __int_as_float(__builtin_amdgcn_update_dpp(0, __float_as_int(send), 0xB1, 0xF, 0xF, false));
        int m = scan_row(blk * 16 + kl, dir, bl);
        Y[(long)m * 1024 + yrow_off] = f2bf(ysel);
      }
      if (blk + 1 < nblk) gstore(cur ^ 1);
      __syncthreads();
    }
  }
}

__device__ __forceinline__ void phase_rw_outprep(const P& p, const u16* R4, const u16* A2, const u16* Y2, u16* G, int bid, int nb) {
  bid = opaque_s(bid);
  const int tid_ = opaque_v(threadIdx.x), lane = tid_ & 63, wid = tid_ >> 6;
  const long T = (long)MR * 1024;
  for (int m = bid * 4 + wid; m < MR; m += nb * 4) {
    long off = (long)m * 1024 + lane * 16;
    float y[16], bon = 0.f, s = 0.f;
#pragma unroll
    for (int hh = 0; hh < 2; hh++) {
      bf16x8 yf = *(const bf16x8*)(Y2 + off + hh * 8), yb = *(const bf16x8*)(Y2 + T + off + hh * 8);
      bf16x8 rv = *(const bf16x8*)(R4 + off + hh * 8), kv = *(const bf16x8*)(R4 + T + off + hh * 8);
      bf16x8 af = *(const bf16x8*)(A2 + off + hh * 8), ab = *(const bf16x8*)(A2 + T + off + hh * 8);
      float ka8[8], rk8[8];
      LD8F(ka8, p.rw_k_a + lane * 16 + hh * 8) LD8F(rk8, p.rw_r_k + lane * 16 + hh * 8)
#pragma unroll
      for (int e = 0; e < 8; e++) {
        float yy = bf2f((u16)yf[e]) + bf2f((u16)yb[e]);
        y[hh * 8 + e] = yy; s += yy;
        float ka = ka8[e], kf = bf2f((u16)kv[e]);
        float kt0 = kf * (1.f + (bf2f((u16)af[e]) - 1.f) * ka), kt1 = kf * (1.f + (bf2f((u16)ab[e]) - 1.f) * ka);
        bon += bf2f((u16)rv[e]) * (kt0 + kt1) * rk8[e];
      }
    }
    s += __shfl_xor(s, 1); s += __shfl_xor(s, 2);
    bon += __shfl_xor(bon, 1); bon += __shfl_xor(bon, 2);
    float mean = s * (1.f / 64.f);
    float vs = 0.f;
#pragma unroll
    for (int e = 0; e < 16; e++) { float dlt = y[e] - mean; vs += dlt * dlt; }
    vs += __shfl_xor(vs, 1); vs += __shfl_xor(vs, 2);
    float rs = rsqrtf(vs * (1.f / 64.f) + 64e-5f);
#pragma unroll
    for (int hh = 0; hh < 2; hh++) {
      bf16x8 vv = *(const bf16x8*)(R4 + 2 * T + off + hh * 8), zv = *(const bf16x8*)(R4 + 3 * T + off + hh * 8);
      bf16x8 o;
      float lg8[8], lb8[8];
      LD8F(lg8, p.rw_lnx_g + lane * 16 + hh * 8) LD8F(lb8, p.rw_lnx_b + lane * 16 + hh * 8)
#pragma unroll
      for (int e = 0; e < 8; e++) {
        float yn = (y[hh * 8 + e] - mean) * rs * lg8[e] + lb8[e];
        o[e] = (short)f2bf((yn + bon * bf2f((u16)vv[e])) * siluf(bf2f((u16)zv[e])));
      }
      *(bf16x8*)(G + off + hh * 8) = o;
    }
  }
}

__device__ __forceinline__ void phase_final(const P& p, int bid, int nb) {
  bid = opaque_s(bid);
  const int tid_ = opaque_v(threadIdx.x), lane = tid_ & 63, wid = tid_ >> 6;
  for (int m = bid * 4 + wid; m < NBATCH * SEQ; m += nb * 4) {
    float* row = p.out + (long)m * 1024;
    float4 v[4]; float ss = 0.f;
#pragma unroll
    for (int i = 0; i < 4; i++) { v[i] = *(const float4*)(row + i * 256 + lane * 4); ss += v[i].x * v[i].x + v[i].y * v[i].y + v[i].z * v[i].z + v[i].w * v[i].w; }
    ss = wave_sum(ss);
    float rs = rsqrtf(ss * (1.f / 1024.f) + 1e-6f);
#pragma unroll
    for (int i = 0; i < 4; i++) {
      float4 g = *(const float4*)(p.final_g + i * 256 + lane * 4);
      float4 o = make_float4(v[i].x * rs * g.x, v[i].y * rs * g.y, v[i].z * rs * g.z, v[i].w * rs * g.w);
      *(float4*)(row + i * 256 + lane * 4) = o;
    }
  }
}

__global__ void __launch_bounds__(256, 2) fwd_megakernel(P p) {
  cg::grid_group grid = cg::this_grid();
  extern __shared__ __attribute__((aligned(16))) float smf[];
  u16* smem = (u16*)smf;
  const int bid = blockIdx.x, nb = gridDim.x;
  char* ws = p.ws;
  float* ctxs = (float*)(ws + OFF_CTXS);
  char* rb = ws + OFF_ROUND;
  __shared__ uint4 xb_words;
  __shared__ __attribute__((aligned(16))) float ysel_unused[4];
  (void)ysel_unused;
  if (threadIdx.x == 0) xb_words = make_uint4(0u, 0u, 0u, 0u);
  __syncthreads();
  XcdBarrier xb = xcd_barrier_post((unsigned*)(ws + OFF_BAR), (volatile LAS unsigned*)&xb_words);

  phase_mods(p, bid, nb, smf);
  __syncthreads();
  phase_weights(p, bid, nb, smf);
  if (gridDim.y > 1) grid.sync();
  xcd_barrier(xb);
  phase_prep(p, 0, 0, p.x, p.ctx, (u16*)rb, bid, nb);
  xcd_barrier(xb);

#pragma unroll 1
  for (int layer = 0; layer < 4; layer++) {
    const int kind = layer % 3, jl = layer / 3;
    const float* xsrc = layer == 0 ? p.x : p.out;
    const float* csrc = layer == 0 ? p.ctx : ctxs;
#pragma unroll 1
    for (int r = 0; r < NROUND; r++) {
      u16* H = (u16*)rb;
#ifndef NO_RET
      if (kind == 0) {
        u16* KT = (u16*)(rb + 1 * SLOT); u16* PB = (u16*)rb;
        u16* Q = (u16*)(rb + 2 * SLOT); u16* Kb = (u16*)(rb + 3 * SLOT);
        u16* VT = (u16*)(rb + 4 * SLOT); u16* Z = (u16*)(rb + 6 * SLOT);
        u16* O = (u16*)(rb + 8 * SLOT); u16* ST = (u16*)(rb + 10 * SLOT);
        u16* KTB = (u16*)(rb + 8 * SLOT);
        phase_ret_inproj(p, r, jl, H, (const u16*)(ws + WB_RET_IN) + (long)jl * 6144 * 1024, Q, Kb, KT, KTB, VT, Z, bid, nb, smem);
        xcd_barrier(xb);
        phase_ret_state(p, jl, KT, KTB, VT, ST, bid, nb, smem);
        xcd_barrier(xb);
        phase_ret_scan(p, jl, ST, bid, nb);
        phase_ret_scores(p, jl, Q, Kb, PB, bid, nb, smem);
        xcd_barrier(xb);
        phase_ret_o(p, jl, Q, VT, PB, ST, O, bid, nb, smem);
        xcd_barrier(xb);
        phase_ret_gate(O, Z, bid, nb);
        xcd_barrier(xb);
        phase_outproj(p, layer, r, O, 2048, (const u16*)(ws + WB_RET_OUT) + (long)jl * 1024 * 2048, xsrc, csrc, p.out, ctxs, bid, nb, smem);
      }
#endif
#ifndef NO_GM
      if (kind == 1) {
        u16* U = (u16*)(rb + 1 * SLOT); u16* VR = (u16*)(rb + 3 * SLOT); u16* Z = (u16*)(rb + 5 * SLOT); u16* VT = (u16*)(rb + 7 * SLOT);
        phase_gm_inproj(H, (const u16*)(ws + WB_GM_IN), U, bid, nb, smem);
        xcd_barrier(xb);
        float* vstats = (float*)(ws + OFF_KINV);
        phase_gm_vstats(VR, vstats, bid, nb);
        xcd_barrier(xb);
        phase_gm_vtrans(p, VR, vstats, VT, bid, nb, smf);
        xcd_barrier(xb);
        phase_gm_spatial(p, (const u16*)(ws + WB_GM_WS), VT, U, Z, bid, nb, smem);
        xcd_barrier(xb);
        phase_outproj(p, layer, r, U, 2048, (const u16*)(ws + WB_GM_OUT), xsrc, csrc, p.out, ctxs, bid, nb, smem);
      }
#endif
#ifndef NO_RW
      if (kind == 2) {
        u16* R4 = (u16*)(rb + 1 * SLOT); u16* OM2 = (u16*)(rb + 5 * SLOT); u16* A2 = (u16*)(rb + 7 * SLOT); u16* Y2 = (u16*)(rb + 9 * SLOT);
        u16* LW = (u16*)(ws + OFF_LW); float* kinv = (float*)(ws + OFF_KINV);
        u16* XM = (u16*)(rb + 5 * SLOT);
        phase_rw_mix(p, r, H, XM, bid, nb);
        xcd_barrier(xb);
        phase_rw_gemm1(p, r, XM, (const u16*)(ws + WB_RW_G1), R4, LW, bid, nb, smem);
        xcd_barrier(xb);
        phase_rw_gemm2(p, LW, (const u16*)(ws + WB_RW_G2), OM2, A2, R4 + (long)MR * 1024, kinv, bid, nb, smem);
        xcd_barrier(xb);
        phase_rw_scan(p, R4, OM2, A2, kinv, Y2, bid, nb, smf);
        xcd_barrier(xb);
        u16* GW = (u16*)(rb + 11 * SLOT);
        phase_rw_outprep(p, R4, A2, Y2, GW, bid, nb);
        xcd_barrier(xb);
        phase_outproj(p, layer, r, GW, 1024, (const u16*)(ws + WB_RW_OUT), xsrc, csrc, p.out, ctxs, bid, nb, smem);
      }
#endif
      {
        int nl = layer, nr = r + 1;
        if (nr == NROUND) { nr = 0; nl = layer + 1; }
        const int skipb = (layer == 3) ? 0 : 32;
        if (nl < 4 && bid >= skipb) phase_prep(p, nl, nr, nl == 0 ? p.x : p.out, nl == 0 ? p.ctx : ctxs, H, bid - skipb, nb - skipb);
      }
      xcd_barrier(xb);
    }
  }
  phase_final(p, bid, nb);
}

extern "C" void kernel_launch(void* const* d_in, const int* in_sizes, int n_in, void* d_out, int out_size, void* d_ws,
                              size_t ws_size, hipStream_t stream) {
  static int grid_blocks = 0;
  if (!grid_blocks) {
    int dev = 0, cus = 0, per_cu = 0;
    (void)hipGetDevice(&dev);
    (void)hipDeviceGetAttribute(&cus, hipDeviceAttributeMultiprocessorCount, dev);
    (void)hipFuncSetAttribute((const void*)fwd_megakernel, hipFuncAttributeMaxDynamicSharedMemorySize, 65536);
    (void)hipOccupancyMaxActiveBlocksPerMultiprocessor(&per_cu, fwd_megakernel, 256, 65536);
    if (per_cu > 2) per_cu = 2;
    if (per_cu < 1) per_cu = 1;
    grid_blocks = cus * per_cu;
  }
  if ((size_t)WS_NEED > ws_size) fprintf(stderr, "workspace too small: need %ld have %zu\n", (long)WS_NEED, ws_size);
  P p{};
  const float** pp = (const float**)&p;
  for (int i = 0; i < 30; i++) pp[i] = (const float*)d_in[i];
  p.out = (float*)d_out;
  p.ws = (char*)d_ws;
  (void)hipMemsetAsync((char*)d_ws + OFF_BAR, 0, XCD_BAR_WORDS * 4, stream);
  void* args[] = {&p};
  hipError_t e = hipLaunchCooperativeKernel((void*)fwd_megakernel, dim3(grid_blocks), dim3(256), args, 65536, stream);
  if (e != hipSuccess) fprintf(stderr, "cooperative launch failed: %s (grid %d)\n", hipGetErrorString(e), grid_blocks);
}
```
